# Optimizing an MI355X kernel written in HIP

```python
import jax, jax.numpy as jnp
from jax import lax
import numpy as np

D_MODEL = 1024
BATCH = 8
SEQ = 2048
DEPTH = 1

GRID_W = 64
CTX_LEN = 256
MIX_WIDTH = D_MODEL
HGRN_WIDTH = MIX_WIDTH // 2
HGRN_HEAD_DIM = 128
HGRN_HEADS = HGRN_WIDTH // HGRN_HEAD_DIM
FNET_WIDTH = MIX_WIDTH - HGRN_WIDTH
FNET_GROUPS = 4
FNET_GROUP_DIM = FNET_WIDTH // FNET_GROUPS
IN_PROJ_WIDTH = 5 * HGRN_WIDTH + FNET_WIDTH
CHUNK = 64
N_EXPERTS = 32
TOP_K = 4
D_FF = D_MODEL
SWIGLU_LIMIT = 7.0
SWIGLU_ALPHA = 1.702
NORM_EPS = 1e-6
POS_BASE = 10000.0

kernel_name = "hybrid_hgrn2_fnet_moe_dit"


def _rmsnorm(x, g):
    xf = x.astype(jnp.float32)
    y = xf * lax.rsqrt(jnp.mean(xf * xf, axis=-1, keepdims=True) + NORM_EPS)
    return (y * g.astype(jnp.float32)).astype(x.dtype)


def _modulate(h, shift, scale):
    return h * (1 + scale) + shift


def _sincos_2d(rows, cols, dim):
    quarter = dim // 4
    omega = 1.0 / (POS_BASE ** (jnp.arange(quarter, dtype=jnp.float32) / quarter))

    def axis_emb(n):
        ang = jnp.arange(n, dtype=jnp.float32)[:, None] * omega[None, :]
        return jnp.concatenate([jnp.sin(ang), jnp.cos(ang)], axis=-1)

    er = jnp.broadcast_to(axis_emb(rows)[:, None, :], (rows, cols, dim // 2))
    ec = jnp.broadcast_to(axis_emb(cols)[None, :, :], (rows, cols, dim // 2))
    return jnp.concatenate([er, ec], axis=-1).reshape(rows * cols, dim)


def _heads(t):
    b, l, _ = t.shape
    return t.reshape(b, l, HGRN_HEADS, HGRN_HEAD_DIM).transpose(0, 2, 1, 3)


def _gla_chunk(q, k, v, logf, s0):
    b_, h_, l_, dk = q.shape
    dv = v.shape[-1]
    n = l_ // CHUNK
    r = lambda t: t.reshape(b_, h_, n, CHUNK, t.shape[-1])
    q, k, v, g = r(q), r(k), r(v), r(logf)
    bcum = jnp.cumsum(g, axis=3)
    b_ref = bcum[:, :, :, CHUNK // 2 - 1:CHUNK // 2, :]
    qi = q * jnp.exp(bcum - b_ref)
    ki = k * jnp.exp(b_ref - bcum)
    a = jnp.einsum('bhntd,bhnsd->bhnts', qi, ki)
    a = jnp.where(jnp.tril(jnp.ones((CHUNK, CHUNK), dtype=bool)), a, 0.0)
    o_intra = jnp.einsum('bhnts,bhnsv->bhntv', a, v)
    b_last = bcum[:, :, :, -1:, :]
    u = jnp.einsum('bhnsd,bhnsv->bhndv', k * jnp.exp(b_last - bcum), v)
    decay = jnp.exp(b_last[:, :, :, 0, :])

    def step(s, xs):
        d, uu = xs
        return d[..., None] * s + uu, s

    s_final, s_start = lax.scan(step, s0, (jnp.moveaxis(decay, 2, 0), jnp.moveaxis(u, 2, 0)))
    s_start = jnp.moveaxis(s_start, 0, 2)
    o_inter = jnp.einsum('bhntd,bhndv->bhntv', q * jnp.exp(bcum), s_start)
    return (o_intra + o_inter).reshape(b_, h_, l_, dv), s_final


def _gla_dir(q, k, v, logf, s0, reverse):
    if reverse:
        q, k, v, logf = (jnp.flip(t, axis=2) for t in (q, k, v, logf))
    o, s = _gla_chunk(q, k, v, logf, s0)
    if reverse:
        o = jnp.flip(o, axis=2)
    return o, s


def _hgrn_inputs(p, lb):
    w = HGRN_WIDTH
    q = _heads(p[..., :w]).astype(jnp.float32)
    v = _heads(p[..., w:2 * w]).astype(jnp.float32)
    g = p[..., 2 * w:3 * w]
    dirs = []
    for d in range(2):
        z = _heads(p[..., (3 + d) * w:(4 + d) * w]).astype(jnp.float32)
        lbd = lb[d].reshape(HGRN_HEADS, 1, HGRN_HEAD_DIM)
        logf = jnp.log(lbd + (1 - lbd) * jax.nn.sigmoid(z))
        k = (1 - lbd) * jax.nn.sigmoid(-z)
        dirs.append((k, logf))
    return q, v, g, dirs


def _hgrn_out(o, g, gn):
    o = o * lax.rsqrt(jnp.mean(o * o, axis=-1, keepdims=True) + NORM_EPS) * gn.astype(jnp.float32)
    b_, h_, l_, dv = o.shape
    o = o.transpose(0, 2, 1, 3).reshape(b_, l_, h_ * dv)
    return (o * jax.nn.sigmoid(g.astype(jnp.float32))).astype(g.dtype)


def _hgrn_mixer(p_lat, p_ctx, lb, gn):
    ql, vl, gl, dl = _hgrn_inputs(p_lat, lb)
    qc, vc, gc, dc = _hgrn_inputs(p_ctx, lb)
    b_ = p_lat.shape[0]
    s0 = jnp.zeros((b_, HGRN_HEADS, HGRN_HEAD_DIM, HGRN_HEAD_DIM), jnp.float32)
    o_lat = 0.0
    o_ctx = 0.0
    for d, rev in enumerate((False, True)):
        oc, sc = _gla_dir(qc, dc[d][0], vc, dc[d][1], s0, rev)
        ol, _ = _gla_dir(ql, dl[d][0], vl, dl[d][1], sc, rev)
        o_lat = o_lat + ol
        o_ctx = o_ctx + oc
    return _hgrn_out(o_lat, gl, gn), _hgrn_out(o_ctx, gc, gn)


def _fourier_mix(u, w):
    b_, l_, _ = u.shape
    ug = u.reshape(b_, l_, FNET_GROUPS, FNET_GROUP_DIM).astype(jnp.float32)
    f = jnp.fft.fft2(ug, axes=(1, 3), norm='ortho').real
    y = jnp.einsum('blgc,gcd->blgd', f, w.astype(jnp.float32))
    return y.reshape(b_, l_, FNET_WIDTH).astype(u.dtype)


def _moe(h, w_r, b_r, w1, b1, w2, b2):
    b_, l_, d = h.shape
    t = h.reshape(b_ * l_, d)
    logits = (t @ w_r + b_r).astype(jnp.float32)
    top_v, top_i = lax.top_k(logits, TOP_K)
    wts = jax.nn.softmax(top_v, axis=-1)
    gate = jnp.sum(jax.nn.one_hot(top_i, N_EXPERTS, dtype=jnp.float32) * wts[..., None], axis=1)
    gate = gate.astype(t.dtype)
    out = jnp.zeros_like(t)
    for e in range(N_EXPERTS):
        a = t @ w1[e] + b1[e]
        a_glu = jnp.minimum(a[:, :D_FF], SWIGLU_LIMIT)
        a_lin = jnp.clip(a[:, D_FF:], -SWIGLU_LIMIT, SWIGLU_LIMIT)
        hh = a_glu * jax.nn.sigmoid(SWIGLU_ALPHA * a_glu) * (a_lin + 1)
        out = out + gate[:, e:e + 1] * (hh @ w2[e] + b2[e])
    return out.reshape(b_, l_, d)


def _normal(k, shape, s):
    return jax.random.normal(k, shape, jnp.float32) * s


def setup_inputs(seed: int = 0) -> dict:
    key = jax.random.key(seed)
    ks = jax.random.split(key, 20)
    d = D_MODEL
    return {
        "x": _normal(ks[0], (BATCH, SEQ, d), 1.0),
        "c": _normal(ks[1], (BATCH, d), 1.0),
        "ctx": _normal(ks[2], (BATCH, CTX_LEN, d), 1.0),
        "c_ctx": _normal(ks[3], (d,), 1.0),
        "ada_w": _normal(ks[4], (DEPTH, d, 6 * d), d ** -0.5),
        "ada_b": _normal(ks[5], (DEPTH, 6 * d), 0.02),
        "norm1_g": 1.0 + _normal(ks[6], (DEPTH, d), 0.05),
        "w_in": _normal(ks[7], (DEPTH, d, IN_PROJ_WIDTH), d ** -0.5),
        "hgrn_lb": _normal(ks[8], (DEPTH + 1, 2, HGRN_WIDTH), 0.2),
        "hgrn_gnorm": 1.0 + _normal(ks[9], (DEPTH, HGRN_HEAD_DIM), 0.05),
        "fnet_w": _normal(ks[10], (DEPTH, FNET_GROUPS, FNET_GROUP_DIM, FNET_GROUP_DIM), FNET_GROUP_DIM ** -0.5),
        "w_out": _normal(ks[11], (DEPTH, MIX_WIDTH, d), MIX_WIDTH ** -0.5),
        "norm2_g": 1.0 + _normal(ks[12], (DEPTH, d), 0.05),
        "router_w": _normal(ks[13], (DEPTH, d, N_EXPERTS), d ** -0.5),
        "router_b": _normal(ks[14], (DEPTH, N_EXPERTS), 0.01),
        "moe_w1": _normal(ks[15], (DEPTH, N_EXPERTS, d, 2 * D_FF), d ** -0.5),
        "moe_b1": _normal(ks[16], (DEPTH, N_EXPERTS, 2 * D_FF), 0.02),
        "moe_w2": _normal(ks[17], (DEPTH, N_EXPERTS, D_FF, d), D_FF ** -0.5),
        "moe_b2": _normal(ks[18], (DEPTH, N_EXPERTS, d), 0.02),
        "final_g": 1.0 + _normal(ks[19], (d,), 0.05),
    }


def reference(x, c, ctx, c_ctx, ada_w, ada_b, norm1_g, w_in, hgrn_lb, hgrn_gnorm, fnet_w, w_out,
              norm2_g, router_w, router_b, moe_w1, moe_b1, moe_w2, moe_b2, final_g):
    n_lat = x.shape[1]
    rows = n_lat // GRID_W
    x = x + _sincos_2d(rows, GRID_W, D_MODEL).astype(x.dtype)[None]
    lb_all = jnp.cumsum(jax.nn.softmax(hgrn_lb.astype(jnp.float32), axis=0), axis=0)
    w = HGRN_WIDTH
    xc = ctx
    for l in range(DEPTH):
        last = l == DEPTH - 1
        mod_x = jax.nn.silu(c) @ ada_w[l] + ada_b[l]
        mod_c = jax.nn.silu(c_ctx) @ ada_w[l] + ada_b[l]
        mx = jnp.split(mod_x[:, None, :], 6, axis=-1)
        mc = jnp.split(mod_c, 6, axis=-1)
        px = _modulate(_rmsnorm(x, norm1_g[l]), mx[0], mx[1]) @ w_in[l]
        pc = _modulate(_rmsnorm(xc, norm1_g[l]), mc[0], mc[1]) @ w_in[l]
        hx, hc = _hgrn_mixer(px[..., :5 * w], pc[..., :5 * w], lb_all[l], hgrn_gnorm[l])
        fx = _fourier_mix(px[..., 5 * w:], fnet_w[l])
        x = x + mx[2] * (jnp.concatenate([hx, fx], axis=-1) @ w_out[l])
        hm = _modulate(_rmsnorm(x, norm2_g[l]), mx[3], mx[4])
        x = x + mx[5] * _moe(hm, router_w[l], router_b[l], moe_w1[l], moe_b1[l], moe_w2[l], moe_b2[l])
        if not last:
            fc = _fourier_mix(pc[..., 5 * w:], fnet_w[l])
            xc = xc + mc[2] * (jnp.concatenate([hc, fc], axis=-1) @ w_out[l])
            hmc = _modulate(_rmsnorm(xc, norm2_g[l]), mc[3], mc[4])
            xc = xc + mc[5] * _moe(hmc, router_w[l], router_b[l], moe_w1[l], moe_b1[l], moe_w2[l], moe_b2[l])
    return _rmsnorm(x, final_g)
```

```cpp
#include <hip/hip_runtime.h>
#include <cstdio>
#include <cstdint>

#ifndef MK_N_LAUNCHES
#define MK_N_LAUNCHES 1
#endif

#define GAS __attribute__((address_space(1)))
#define LAS __attribute__((address_space(3)))
typedef unsigned short bf16;
typedef unsigned v4u __attribute__((ext_vector_type(4)));
typedef unsigned v2u __attribute__((ext_vector_type(2)));
typedef float f32x4 __attribute__((ext_vector_type(4)));
typedef float f32x2 __attribute__((ext_vector_type(2)));
typedef short bf16x8 __attribute__((ext_vector_type(8)));
typedef GAS unsigned gu32;

constexpr int D = 1024, NB = 8, SEQ = 2048, T = NB * SEQ, CTX = 256, TC = NB * CTX, TA = T + TC;
constexpr int HW = 512, HD = 128, NH = 4, FWID = 512, NG = 4, GD = 128;
constexpr int NPX = 5 * HW;
constexpr int NE = 32, TOPK = 4, DFF = 1024;
constexpr int SLOT_MAX = T * TOPK + NE * 256;
constexpr float NORM_EPS = 1e-6f;
constexpr int NWAVES = 8, NTHR = 512;

constexpr size_t MiB = 1u << 20;
constexpr size_t WS_CTL = 0, CTL_ZERO_BYTES = 1 * MiB;
constexpr size_t WS_MOD = 1 * MiB;
constexpr size_t WS_LB = WS_MOD + 9 * 6144 * 4;
constexpr size_t WS_ROUTE = WS_LB + 4096;
constexpr size_t WS_MG = 3 * MiB;
constexpr size_t WS_POS = 4 * MiB;
constexpr size_t WS_WINT = 12 * MiB;
constexpr size_t WS_WOUT = 19 * MiB;
constexpr size_t WS_DFT = 21 * MiB;
constexpr size_t WS_WB1 = 37 * MiB;
constexpr size_t WS_WB2 = 165 * MiB;
constexpr size_t WS_HMOD = 229 * MiB;
constexpr size_t WS_R1 = 265 * MiB;
constexpr size_t WS_PX = WS_R1;
constexpr size_t WS_PT = WS_PX + 90 * MiB;
constexpr size_t WS_OGLA = WS_PT + 32 * MiB;
constexpr size_t WS_EO = WS_OGLA + 64 * MiB;
constexpr size_t WS_HMP = WS_R1;
constexpr size_t WS_YS = WS_R1;
constexpr size_t WS_MIX = WS_R1 + 218 * MiB;
constexpr size_t WS_X2 = WS_MIX + 32 * MiB;
constexpr size_t WS_HM = WS_X2 + 64 * MiB;
constexpr size_t WS_HH = WS_HM + 32 * MiB;
constexpr size_t WS_END = WS_HH + 144 * MiB;
static_assert(WS_END <= 1024 * MiB, "workspace map");
constexpr int CW_CNT = 64;
constexpr int CW_BAR = 4096;

constexpr int RING_BYTES = 131072;
constexpr int LDSCTL_OFF = RING_BYTES, MISC_OFF = LDSCTL_OFF + 320;
constexpr int LDS_BYTES = 147456;

#define LDS_WAIT() asm volatile("s_waitcnt lgkmcnt(0)" ::: "memory")
#define VM_WAIT() asm volatile("s_waitcnt vmcnt(0)" ::: "memory")
__device__ __forceinline__ unsigned f2bf(float f) { unsigned u = __builtin_bit_cast(unsigned, f); return (u + 0x7fffu + ((u >> 16) & 1u)) >> 16; }
__device__ __forceinline__ unsigned pk2(float lo, float hi) { return f2bf(lo) | (f2bf(hi) << 16); }
__device__ __forceinline__ float bf2f(unsigned short b) { return __builtin_bit_cast(float, ((unsigned)b) << 16); }
__device__ __forceinline__ float bflo(unsigned u) { return __builtin_bit_cast(float, u << 16); }
__device__ __forceinline__ float bfhi(unsigned u) { return __builtin_bit_cast(float, u & 0xffff0000u); }
__device__ __forceinline__ float sigmoidf_(float x) { return __builtin_amdgcn_rcpf(1.0f + __expf(-x)); }

#define XB_TMO      128
#define XB_XCNT(j)  (256  + 64 * (j))
#define XB_XSUB(j)  (1280 + 64 * (j))
#define XB_XGEN(j)  (2304 + 64 * (j))
#define XB_TOP      3328
#define XB_TOPGEN   3392
#define XCD_BAR_WORDS 3456
#define XB_SPIN_CAP (1u << 18)
__device__ __forceinline__ unsigned xb_ld(unsigned* p)              { return __hip_atomic_load(p, __ATOMIC_RELAXED, __HIP_MEMORY_SCOPE_AGENT); }
__device__ __forceinline__ unsigned xb_add(unsigned* p, unsigned v) { return __hip_atomic_fetch_add(p, v, __ATOMIC_RELAXED, __HIP_MEMORY_SCOPE_AGENT); }
__device__ __forceinline__ unsigned xb_xcc_id() { return (unsigned)__builtin_amdgcn_s_getreg((3 << 11) | 20) & 0xFu; }
#define XB_SPIN(cond, bar) do { unsigned _sp = 0; while (cond) { __builtin_amdgcn_s_sleep(1); \
    if ((++_sp & 255u) == 0u) { if (xb_ld(&(bar)[XB_TMO])) break; if (_sp > XB_SPIN_CAP) { atomicAdd(&(bar)[XB_TMO], 1u); break; } } } } while (0)
struct XcdBarrier { unsigned* bar; unsigned x; volatile LAS unsigned* st; };
__device__ __forceinline__ XcdBarrier xcd_barrier_post(unsigned* bar, volatile LAS unsigned* st) {
    XcdBarrier b; b.bar = bar; b.x = xb_xcc_id(); b.st = st;
    if (threadIdx.x == 0) (void)xb_add(&bar[XB_XCNT(b.x)], 1u);
    return b;
}
__device__ __forceinline__ void xcd_barrier_complete(unsigned* bar, unsigned x, unsigned& nloc, unsigned& nx) {
    const unsigned G = gridDim.x * gridDim.y * gridDim.z;
    unsigned sum, cnt, mine, sp = 0u;
    for (;;) {
        sum = 0u; cnt = 0u; mine = 0u;
#pragma unroll
        for (unsigned j = 0; j < 16; ++j) { const unsigned c = xb_ld(&bar[XB_XCNT(j)]); sum += c; cnt += (c > 0u) ? 1u : 0u; mine = (j == x) ? c : mine; }
        if (sum == G) break;
        __builtin_amdgcn_s_sleep(1);
        if ((++sp & 255u) == 0u) { if (xb_ld(&bar[XB_TMO])) break; if (sp > XB_SPIN_CAP) { atomicAdd(&bar[XB_TMO], 1u); break; } }
    }
    nloc = mine > 0u ? mine : 1u; nx = cnt > 0u ? cnt : 1u;
}
__device__ __forceinline__ void xcd_barrier(const XcdBarrier& b) {
    asm volatile("s_waitcnt vmcnt(0)" ::: "memory");
    __syncthreads();
    if (threadIdx.x == 0) {
        unsigned* bar = b.bar;
        __builtin_amdgcn_s_waitcnt(0);
        unsigned nloc = b.st[0], nx = b.st[1];
        if (nloc == 0u) { xcd_barrier_complete(bar, b.x, nloc, nx); b.st[0] = nloc; b.st[1] = nx; }
        const unsigned old = xb_add(&bar[XB_XSUB(b.x)], 1u);
        const unsigned gen = old / nloc;
        if (old + 1u == (gen + 1u) * nloc) {
            __builtin_amdgcn_fence(__ATOMIC_RELEASE, "agent");
            asm volatile("s_waitcnt vmcnt(0)" ::: "memory");
            const unsigned og = xb_add(&bar[XB_TOP], 1u);
            const unsigned tg = og / nx;
            if (og + 1u == (tg + 1u) * nx) xb_add(&bar[XB_TOPGEN], 1u);
            else XB_SPIN(xb_ld(&bar[XB_TOPGEN]) == tg, bar);
            __builtin_amdgcn_fence(__ATOMIC_ACQUIRE, "agent");
            xb_add(&bar[XB_XGEN(b.x)], 1u);
            asm volatile("s_waitcnt vmcnt(0)" ::: "memory");
        } else {
            XB_SPIN(xb_ld(&bar[XB_XGEN(b.x)]) == gen, bar);
            __builtin_amdgcn_fence(__ATOMIC_ACQUIRE, "agent");
            asm volatile("s_waitcnt vmcnt(0)" ::: "memory");
        }
    }
    __syncthreads();
}

namespace pg8 {
constexpr int BM = 256, BK = 64, HALF = 128, HTB = HALF * BK * 2, NXCD = 8, WGM = 8;
__host__ __device__ __forceinline__ int lds_byte(int r, int c) { const int st = (r >> 4) * 2 + (c >> 5), rr = r & 15, cc = c & 31, ob = rr * 64 + cc * 2; return st * 1024 + (ob ^ (((ob >> 9) & 1) << 5)); }
__host__ __device__ __forceinline__ void stage_rc(int b, int& R, int& C) { const int st = b / 1024, sb = b % 1024, swz = sb ^ (((sb >> 9) & 1) << 5); R = (st >> 1) * 16 + swz / 64; C = (st & 1) * 32 + (swz % 64) / 2; }
__host__ __device__ __forceinline__ int perm32(int rho) { const int n = rho >> 4, i = rho & 15; return 8 * (i >> 2) + 4 * n + (i & 3); }

struct Unit { const char* a; const char* b; char* o; int i0, i1, i2, i3; };

__device__ __forceinline__ void tile_of(int L, int nM, int nN, int& pm, int& pn) {
    const int nwg = nM * nN; int wgid = L;
    { const int q = nwg / NXCD, r = nwg % NXCD, xcd = wgid % NXCD, off = wgid / NXCD; wgid = (xcd < r ? xcd * (q + 1) : r * (q + 1) + (xcd - r) * q) + off; }
    const int nig = WGM * nN, gid = wgid / nig, fm = gid * WGM, gsz = (nM - fm) < WGM ? (nM - fm) : WGM;
    pm = fm + ((wgid % nig) % gsz); pn = (wgid % nig) / gsz;
}
__device__ __forceinline__ unsigned cvt_pk_bf16(float lo, float hi) { unsigned r; asm volatile("v_cvt_pk_bf16_f32 %0, %1, %2" : "=v"(r) : "v"(lo), "v"(hi)); return r; }

template <class Epi, class Sched>
__device__ __forceinline__ void gemm_phase(LAS unsigned char* lds, const int K, const size_t hsA, const size_t hsB, const Sched& S, const Epi& E) {
    const int tid = threadIdx.x, wid = __builtin_amdgcn_readfirstlane(tid >> 6), lane = tid & 63, wr = wid >> 2, wc = wid & 3, fr = lane & 15, fq = lane >> 4;
    const int nt = K / BK;
    unsigned voffA[2], voffB[2];
#pragma unroll
    for (int i = 0; i < 2; ++i) { int R, C; stage_rc(tid * 16 + i * 8192, R, C); const int Rb = Epi::PERM ? ((R & ~31) + perm32(R & 31)) : R;
        voffA[i] = (unsigned)(R * K + C) * 2u; voffB[i] = (unsigned)(Rb * K + C) * 2u; }
    const size_t kstep = (size_t)(BK * 2);
    const unsigned ldsw = (unsigned)wid * 1024u;
    const int aoff = lds_byte(wr * 64 + fr, fq * 8), boff = lds_byte(wc * 32 + fr, fq * 8);
#define PG8_SA(b, h) (((b) * 2 + (h)) * HTB)
#define PG8_SB(b, h) ((4 + (b) * 2 + (h)) * HTB)
#define PG8_STAGE(bufoff, gbase, voff) do { _Pragma("unroll") for (int _i = 0; _i < 2; ++_i) \
        __builtin_amdgcn_global_load_lds((const unsigned*)((const char*)(gbase) + (voff)[_i]), (LAS unsigned*)(lds + (bufoff) + ldsw + _i * 8192), 16, 0, 0); } while (0)
#define PG8_LDA(dst, b, h) do { _Pragma("unroll") for (int m = 0; m < 4; ++m) _Pragma("unroll") for (int k = 0; k < 2; ++k) dst[m][k] = *(const LAS bf16x8*)(lds + PG8_SA(b, h) + aoff + m * 2048 + k * 1024); } while (0)
#define PG8_LDB(dst, b, h) do { _Pragma("unroll") for (int n = 0; n < 2; ++n) _Pragma("unroll") for (int k = 0; k < 2; ++k) dst[n][k] = *(const LAS bf16x8*)(lds + PG8_SB(b, h) + boff + n * 2048 + k * 1024); } while (0)
#define PG8_MMA(ai, bj, At, Bt) do { __builtin_amdgcn_s_setprio(1); _Pragma("unroll") for (int m = 0; m < 4; ++m) _Pragma("unroll") for (int n = 0; n < 2; ++n) _Pragma("unroll") for (int k = 0; k < 2; ++k) \
        acc[ai][bj][m][n] = __builtin_amdgcn_mfma_f32_16x16x32_bf16(Bt[n][k], At[m][k], acc[ai][bj][m][n], 0, 0, 0); __builtin_amdgcn_s_setprio(0); } while (0)
#define PG8_WAIT_V(n) asm volatile("s_waitcnt vmcnt(" #n ")" ::: "memory")
#define PG8_WAIT_L(n) asm volatile("s_waitcnt lgkmcnt(" #n ")" ::: "memory")
#define PG8_BAR __builtin_amdgcn_s_barrier()
#define PG8_SCHED __builtin_amdgcn_sched_barrier(0)
    Unit cur, nxt; int ui = 0;
    if (!S.next(0, cur)) return;
    f32x4 acc[2][2][4][2];
#pragma unroll
    for (int a = 0; a < 2; ++a)
#pragma unroll
        for (int b = 0; b < 2; ++b)
#pragma unroll
            for (int m = 0; m < 4; ++m)
#pragma unroll
                for (int n = 0; n < 2; ++n) acc[a][b][m][n] = (f32x4){0.f, 0.f, 0.f, 0.f};
    bf16x8 At[4][2], B0[2][2], B1[2][2];
    const char* cA = cur.a; const char* cB = cur.b;
    PG8_STAGE(PG8_SB(0, 0), cB, voffB); PG8_STAGE(PG8_SB(0, 1), cB + hsB, voffB); PG8_STAGE(PG8_SA(0, 0), cA, voffA); PG8_STAGE(PG8_SA(0, 1), cA + hsA, voffA);
    if (wr == 1) PG8_BAR;
    PG8_WAIT_V(2); PG8_BAR;
    PG8_STAGE(PG8_SB(1, 0), cB + kstep, voffB); PG8_STAGE(PG8_SA(1, 0), cA + kstep, voffA); PG8_STAGE(PG8_SB(1, 1), cB + hsB + kstep, voffB);
    PG8_WAIT_V(6); PG8_BAR;
    for (;;) {
        const bool has_next = S.next(ui + 1, nxt);
        const char* nA = has_next ? nxt.a : cA; const char* nB = has_next ? nxt.b : cB;
        for (int t = 0; t < nt; t += 2) {
            const bool last = (t == nt - 2);
            const char* a1 = cA + (size_t)(t + 1) * kstep;
            const char* a2 = last ? nA : cA + (size_t)(t + 2) * kstep; const char* b2 = last ? nB : cB + (size_t)(t + 2) * kstep;
            const char* a3 = a2 + kstep; const char* b3 = b2 + kstep;
            PG8_LDB(B0, 0, 0); PG8_LDB(B1, 0, 1); PG8_SCHED; PG8_LDA(At, 0, 0); PG8_STAGE(PG8_SA(1, 1), a1 + hsA, voffA);
            PG8_WAIT_V(8); PG8_WAIT_L(0); PG8_BAR; PG8_MMA(0, 0, At, B0); PG8_MMA(0, 1, At, B1); PG8_BAR; PG8_SCHED;
            PG8_LDA(At, 0, 1); PG8_STAGE(PG8_SB(0, 0), b2, voffB); PG8_STAGE(PG8_SB(0, 1), b2 + hsB, voffB); PG8_STAGE(PG8_SA(0, 0), a2, voffA);
            PG8_WAIT_V(8); PG8_WAIT_L(0); PG8_BAR; PG8_MMA(1, 0, At, B0); PG8_MMA(1, 1, At, B1); PG8_BAR; PG8_SCHED;
            PG8_LDB(B0, 1, 0); PG8_LDB(B1, 1, 1); PG8_SCHED; PG8_LDA(At, 1, 0); PG8_STAGE(PG8_SA(0, 1), a2 + hsA, voffA);
            PG8_WAIT_V(8); PG8_WAIT_L(0); PG8_BAR; PG8_MMA(0, 0, At, B0); PG8_MMA(0, 1, At, B1); PG8_BAR; PG8_SCHED;
            PG8_LDA(At, 1, 1); PG8_STAGE(PG8_SB(1, 0), b3, voffB); PG8_STAGE(PG8_SB(1, 1), b3 + hsB, voffB); PG8_STAGE(PG8_SA(1, 0), a3, voffA);
            PG8_WAIT_V(8); PG8_WAIT_L(0); PG8_BAR; PG8_MMA(1, 0, At, B0); PG8_MMA(1, 1, At, B1); PG8_BAR; PG8_SCHED;
        }
        if (wr == 0) PG8_BAR;
        E(acc, cur, wr, wc, fr, fq);
        if (!has_next) break;
#pragma unroll
        for (int a = 0; a < 2; ++a)
#pragma unroll
            for (int b = 0; b < 2; ++b)
#pragma unroll
                for (int m = 0; m < 4; ++m)
#pragma unroll
                    for (int n = 0; n < 2; ++n) acc[a][b][m][n] = (f32x4){0.f, 0.f, 0.f, 0.f};
        cur = nxt; cA = nA; cB = nB; ++ui;
        if (wr == 1) PG8_BAR;
    }
    PG8_WAIT_V(0);
    PG8_BAR;
#undef PG8_SA
#undef PG8_SB
#undef PG8_STAGE
#undef PG8_LDA
#undef PG8_LDB
#undef PG8_MMA
#undef PG8_WAIT_V
#undef PG8_WAIT_L
#undef PG8_BAR
#undef PG8_SCHED
}

struct EpiStoreBf16 {
    static constexpr bool PERM = true;
    __device__ __forceinline__ void operator()(const f32x4 (&acc)[2][2][4][2], const Unit& u, int wr, int wc, int fr, int fq) const {
        bf16* base = (bf16*)u.o; const size_t ld = (size_t)u.i0;
        const int row0 = wr * 64 + fr, col0 = wc * 32 + 8 * fq;
#pragma unroll
        for (int ai = 0; ai < 2; ++ai)
#pragma unroll
            for (int m = 0; m < 4; ++m) { bf16* rowp = base + (size_t)(row0 + ai * HALF + m * 16) * ld + col0;
#pragma unroll
                for (int bj = 0; bj < 2; ++bj) { const f32x4 v0 = acc[ai][bj][m][0], v1 = acc[ai][bj][m][1];
                    v4u w; w.x = cvt_pk_bf16(v0[0], v0[1]); w.y = cvt_pk_bf16(v0[2], v0[3]); w.z = cvt_pk_bf16(v1[0], v1[1]); w.w = cvt_pk_bf16(v1[2], v1[3]);
                    *(v4u*)(rowp + bj * HALF) = w; } }
    }
};
struct EpiWout {
    static constexpr bool PERM = false;
    const float* x; const float* pos; const float* mod; float* x2;
    __device__ __forceinline__ void operator()(const f32x4 (&acc)[2][2][4][2], const Unit& u, int wr, int wc, int fr, int fq) const {
        const int row0 = u.i0 + wr * 64 + fr, col0 = u.i1 + wc * 32 + 4 * fq; const int b = u.i0 >> 11;
        f32x4 gv[2][2];
#pragma unroll
        for (int bj = 0; bj < 2; ++bj)
#pragma unroll
            for (int n = 0; n < 2; ++n) gv[bj][n] = *(const f32x4*)(mod + b * 6144 + 2 * D + col0 + bj * HALF + n * 16);
#pragma unroll
        for (int ai = 0; ai < 2; ++ai)
#pragma unroll
            for (int m = 0; m < 4; ++m) { const int t = row0 + ai * HALF + m * 16; const size_t ro = (size_t)t * D + col0; const size_t po = (size_t)(t & (SEQ - 1)) * D + col0;
#pragma unroll
                for (int bj = 0; bj < 2; ++bj)
#pragma unroll
                    for (int n = 0; n < 2; ++n) { const int co = bj * HALF + n * 16;
                        const f32x4 xv = *(const f32x4*)(x + ro + co), pv = *(const f32x4*)(pos + po + co);
                        *(f32x4*)(x2 + ro + co) = xv + pv + gv[bj][n] * acc[ai][bj][m][n]; } }
    }
};
struct EpiMoe1 {
    static constexpr bool PERM = true;
    const float* b1; bf16* hh;
    __device__ __forceinline__ void operator()(const f32x4 (&acc)[2][2][4][2], const Unit& u, int wr, int wc, int fr, int fq) const {
        const int row0 = u.i0 + wr * 64 + fr, col0 = u.i1 * HALF + wc * 32 + 8 * fq;
        const float* bb = b1 + (size_t)u.i2 * (2 * DFF) + col0;
        f32x4 bg[2], bl[2];
#pragma unroll
        for (int n = 0; n < 2; ++n) { bg[n] = *(const f32x4*)(bb + 4 * n); bl[n] = *(const f32x4*)(bb + DFF + 4 * n); }
#pragma unroll
        for (int ai = 0; ai < 2; ++ai)
#pragma unroll
            for (int m = 0; m < 4; ++m) { bf16* rowp = hh + (size_t)(row0 + ai * HALF + m * 16) * DFF + col0;
                float r[8];
#pragma unroll
                for (int n = 0; n < 2; ++n) { const f32x4 g = acc[ai][0][m][n] + bg[n], l = acc[ai][1][m][n] + bl[n];
#pragma unroll
                    for (int j = 0; j < 4; ++j) { const float ag = fminf(g[j], 7.0f), al = fminf(fmaxf(l[j], -7.0f), 7.0f);
                        r[4 * n + j] = ag * sigmoidf_(1.702f * ag) * (al + 1.0f); } }
                v4u w; w.x = cvt_pk_bf16(r[0], r[1]); w.y = cvt_pk_bf16(r[2], r[3]); w.z = cvt_pk_bf16(r[4], r[5]); w.w = cvt_pk_bf16(r[6], r[7]);
                *(v4u*)rowp = w; }
    }
};
struct EpiMoe2 {
    static constexpr bool PERM = true;
    const float* b2; bf16* ys;
    __device__ __forceinline__ void operator()(const f32x4 (&acc)[2][2][4][2], const Unit& u, int wr, int wc, int fr, int fq) const {
        const int row0 = u.i0 + wr * 64 + fr, col0 = u.i1 * BM + wc * 32 + 8 * fq;
        const float* bb = b2 + (size_t)u.i2 * D + col0;
        f32x4 bv[2][2];
#pragma unroll
        for (int bj = 0; bj < 2; ++bj)
#pragma unroll
            for (int n = 0; n < 2; ++n) bv[bj][n] = *(const f32x4*)(bb + bj * HALF + 4 * n);
#pragma unroll
        for (int ai = 0; ai < 2; ++ai)
#pragma unroll
            for (int m = 0; m < 4; ++m) { bf16* rowp = ys + (size_t)(row0 + ai * HALF + m * 16) * D + col0;
#pragma unroll
                for (int bj = 0; bj < 2; ++bj) { const f32x4 v0 = acc[ai][bj][m][0] + bv[bj][0], v1 = acc[ai][bj][m][1] + bv[bj][1];
                    v4u w; w.x = cvt_pk_bf16(v0[0], v0[1]); w.y = cvt_pk_bf16(v0[2], v0[3]); w.z = cvt_pk_bf16(v1[0], v1[1]); w.w = cvt_pk_bf16(v1[2], v1[3]);
                    *(v4u*)(rowp + bj * HALF) = w; } }
    }
};
}

struct Frame {
    LAS unsigned char* lds; volatile LAS unsigned* MISC; gu32* ctl;
    int tid, lane, wave, G, bid;
    const float* in[20]; float* out; unsigned char* ws;
};
enum { I_X = 0, I_C, I_CTX, I_CCTX, I_ADAW, I_ADAB, I_N1G, I_WIN, I_LB, I_GN, I_FNW, I_WOUT, I_N2G, I_RW, I_RB, I_W1, I_B1, I_W2, I_B2, I_FG };

__device__ __forceinline__ float wave_sum(float v) {
#pragma unroll
    for (int o = 1; o < 64; o <<= 1) v += __shfl_xor(v, o);
    return v;
}
__device__ __forceinline__ float wave_max(float v) {
#pragma unroll
    for (int o = 1; o < 64; o <<= 1) v = fmaxf(v, __shfl_xor(v, o));
    return v;
}

__device__ __forceinline__ void p0_transpose_item(const float* W, int ldw, int K, int nblk, bf16* WT, LAS float* scr, int item, int lane) {
    const int kb = item / nblk, nb = item % nblk, k0 = 64 * kb, n0 = 32 * nb;
#pragma unroll 8
    for (int i = 0; i < 32; ++i) { const int kk = 2 * i + (lane >> 5); scr[kk * 33 + (lane & 31)] = W[(size_t)(k0 + kk) * ldw + n0 + (lane & 31)]; }
    LDS_WAIT(); asm volatile("" ::: "memory");
    const int c = lane & 7;
#pragma unroll
    for (int j = 0; j < 4; ++j) { const int n = (lane >> 3) + 8 * j; const LAS float* s = scr + (8 * c) * 33 + n;
        v4u o; o.x = pk2(s[0 * 33], s[1 * 33]); o.y = pk2(s[2 * 33], s[3 * 33]); o.z = pk2(s[4 * 33], s[5 * 33]); o.w = pk2(s[6 * 33], s[7 * 33]);
        *(GAS v4u*)(WT + (size_t)(n0 + n) * K + k0 + 8 * c) = o; }
    LDS_WAIT(); asm volatile("" ::: "memory");
}
__device__ __forceinline__ void p0_ada_task(Frame& F, int j) {
    LAS float* s = (LAS float*)F.lds;
    LAS float* red = (LAS float*)(F.lds + 9 * 1024 * 4);
    for (int i = F.tid; i < 9 * 1024; i += NTHR) { const int r = i >> 10, k = i & 1023; const float c = (r < 8) ? F.in[I_C][r * 1024 + k] : F.in[I_CCTX][k]; s[i] = c * sigmoidf_(c); }
    __syncthreads();
    const float* aw = F.in[I_ADAW] + (size_t)(128 * F.wave) * 6144 + 64 * j + F.lane;
    float acc[9];
#pragma unroll
    for (int r = 0; r < 9; ++r) acc[r] = 0.f;
    for (int k0 = 0; k0 < 128; k0 += 8) {
        float a[8];
#pragma unroll
        for (int u = 0; u < 8; ++u) a[u] = aw[(size_t)(k0 + u) * 6144];
#pragma unroll
        for (int u = 0; u < 8; ++u)
#pragma unroll
            for (int r = 0; r < 9; ++r) acc[r] += s[r * 1024 + 128 * F.wave + k0 + u] * a[u];
    }
#pragma unroll
    for (int r = 0; r < 9; ++r) red[(F.wave * 9 + r) * 64 + F.lane] = acc[r];
    __syncthreads();
    float* mod = (float*)(F.ws + WS_MOD);
    for (int i = F.tid; i < 9 * 64; i += NTHR) { const int r = i >> 6, l = i & 63; float v = F.in[I_ADAB][64 * j + l];
#pragma unroll
        for (int w = 0; w < 8; ++w) v += red[(w * 9 + r) * 64 + l];
        mod[r * 6144 + 64 * j + l] = v; }
    __syncthreads();
}
__device__ __forceinline__ void p0_prologue(Frame& F) {
    const int gtid = F.bid * NTHR + F.tid, NGT = F.G * NTHR;
    for (int j = F.bid; j < 96; j += F.G) p0_ada_task(F, j);
    if (F.bid == (96 % F.G)) { float* lb = (float*)(F.ws + WS_LB); for (int i = F.tid; i < 2 * HW; i += NTHR) { const float a = F.in[I_LB][i], b = F.in[I_LB][2 * HW + i]; lb[i] = 1.0f / (1.0f + __expf(b - a)); } }
    { float* pos = (float*)(F.ws + WS_POS);
      for (int i = gtid; i < SEQ * D; i += NGT) { const int l = i >> 10, c = i & 1023, q = c >> 8, j = c & 255;
          const float om = exp2f(-(float)j * (13.287712379549449f / 256.0f)); const float p = (float)((q < 2) ? (l >> 6) : (l & 63)); const float ang = p * om;
          pos[i] = (q & 1) ? cosf(ang) : sinf(ang); } }
    { float* mg = (float*)(F.ws + WS_MG);
      for (int i = gtid; i < NG * GD * 2 * GD; i += NGT) { const int j = i & 255, c = (i >> 8) & 127, g = i >> 15; const int jj = j & 127; const bool isS = j >= 128;
          const float* fw = F.in[I_FNW] + (size_t)g * GD * GD + jj; float acc = 0.f;
          for (int cp = 0; cp < GD; ++cp) { const int m = (c * cp) & 127; float sv, cv; sincospif((float)m * (1.0f / 64.0f), &sv, &cv); acc += (isS ? sv : cv) * fw[cp * GD]; }
          mg[i] = acc * 0.08838834764831845f; } }
    { bf16* dc = (bf16*)(F.ws + WS_DFT); bf16* ds = dc + (size_t)SEQ * SEQ;
      for (int i = gtid; i < SEQ * SEQ / 8; i += NGT) { const int k = i >> 8, l0 = (i & 255) * 8; float cv[8], sv[8];
#pragma unroll
          for (int u = 0; u < 8; ++u) { const int m = (k * (l0 + u)) & 2047; sincospif((float)m * (1.0f / 1024.0f), &sv[u], &cv[u]); cv[u] *= 0.022097086912079608f; sv[u] *= 0.022097086912079608f; }
          v4u a, b; a.x = pk2(cv[0], cv[1]); a.y = pk2(cv[2], cv[3]); a.z = pk2(cv[4], cv[5]); a.w = pk2(cv[6], cv[7]);
          b.x = pk2(sv[0], sv[1]); b.y = pk2(sv[2], sv[3]); b.z = pk2(sv[4], sv[5]); b.w = pk2(sv[6], sv[7]);
          *(v4u*)(dc + (size_t)k * SEQ + l0) = a; *(v4u*)(ds + (size_t)k * SEQ + l0) = b; } }
    LAS float* scr = (LAS float*)(F.lds + F.wave * 16384);
    const int gw = F.bid * NWAVES + F.wave, NGW = F.G * NWAVES;
    constexpr int I_IN = 16 * (NPX / 32), I_OUT = 16 * 32, I_1 = 16 * 64, I_2 = 16 * 32;
    constexpr int NITEMS = I_IN + I_OUT + NE * I_1 + NE * I_2;
    for (int it = gw; it < NITEMS; it += NGW) {
        int r = it;
        if (r < I_IN) { p0_transpose_item(F.in[I_WIN], 3072, D, NPX / 32, (bf16*)(F.ws + WS_WINT), scr, r, F.lane); continue; } r -= I_IN;
        if (r < I_OUT) { p0_transpose_item(F.in[I_WOUT], D, D, 32, (bf16*)(F.ws + WS_WOUT), scr, r, F.lane); continue; } r -= I_OUT;
        if (r < NE * I_1) { const int e = r / I_1; p0_transpose_item(F.in[I_W1] + (size_t)e * D * 2 * DFF, 2 * DFF, D, 64, (bf16*)(F.ws + WS_WB1) + (size_t)e * 2 * DFF * D, scr, r % I_1, F.lane); continue; } r -= NE * I_1;
        { const int e = r / I_2; p0_transpose_item(F.in[I_W2] + (size_t)e * DFF * D, D, DFF, 32, (bf16*)(F.ws + WS_WB2) + (size_t)e * D * DFF, scr, r % I_2, F.lane); }
    }
}

__device__ __forceinline__ void p1_row(Frame& F, int t) {
    const float* mod = (const float*)(F.ws + WS_MOD); const float* g1 = F.in[I_N1G];
    const bool lat = t < T; const int b = lat ? (t >> 11) : 8;
    const GAS f32x4* xr = (const GAS f32x4*)(lat ? F.in[I_X] + (size_t)t * D : F.in[I_CTX] + (size_t)(t - T) * D) + F.lane;
    const GAS f32x4* pr = (const GAS f32x4*)((const float*)(F.ws + WS_POS) + (size_t)(t & (SEQ - 1)) * D) + F.lane;
    f32x4 v[4]; float ss = 0.f;
#pragma unroll
    for (int j = 0; j < 4; ++j) { v[j] = xr[64 * j]; if (lat) v[j] = v[j] + pr[64 * j]; ss += (v[j].x * v[j].x + v[j].y * v[j].y) + (v[j].z * v[j].z + v[j].w * v[j].w); }
    const float rinv = 1.0f / sqrtf(wave_sum(ss) * (1.0f / D) + NORM_EPS);
    GAS unsigned long long* o8 = (GAS unsigned long long*)((bf16*)(F.ws + WS_HMOD) + (size_t)t * D) + F.lane;
#pragma unroll
    for (int j = 0; j < 4; ++j) { const int c = 4 * F.lane + 256 * j;
        const f32x4 g = *(const f32x4*)(g1 + c), sh = *(const f32x4*)(mod + b * 6144 + c), sc = *(const f32x4*)(mod + b * 6144 + D + c);
        const f32x4 h = v[j] * rinv * g * (sc + 1.0f) + sh;
        o8[64 * j] = (unsigned long long)pk2(h.x, h.y) | ((unsigned long long)pk2(h.z, h.w) << 32); }
}
__device__ __forceinline__ void p1_fold_task(Frame& F, int task) {
    const int kb = task & 15, pq = (task >> 4) & 1, g = task >> 5, k0 = 64 * kb;
    LAS float* wt = (LAS float*)F.lds;
    LAS float* mh = (LAS float*)(F.lds + 64 * 129 * 4);
    const float* mg = (const float*)(F.ws + WS_MG) + (size_t)g * GD * 256 + pq * 128;
    for (int i = F.tid; i < 64 * 128; i += NTHR) { const int kk = i >> 7, c = i & 127; wt[kk * 129 + c] = F.in[I_WIN][(size_t)(k0 + kk) * 3072 + NPX + g * GD + c]; }
    for (int i = F.tid; i < 128 * 128; i += NTHR) { const int c = i >> 7, j = i & 127; mh[i] = mg[c * 256 + j]; }
    __syncthreads();
    const int kk = F.tid & 63, jg = F.tid >> 6;
    float acc[16];
#pragma unroll
    for (int i = 0; i < 16; ++i) acc[i] = 0.f;
    for (int c = 0; c < 128; ++c) { const float w = wt[kk * 129 + c]; const LAS f32x4* m4 = (const LAS f32x4*)(mh + c * 128 + jg * 16);
#pragma unroll
        for (int q = 0; q < 4; ++q) { const f32x4 mv = m4[q]; acc[4 * q] += w * mv.x; acc[4 * q + 1] += w * mv.y; acc[4 * q + 2] += w * mv.z; acc[4 * q + 3] += w * mv.w; } }
    bf16* wf = (bf16*)(F.ws + WS_WINT) + (size_t)NPX * D;
#pragma unroll
    for (int i = 0; i < 16; ++i) wf[(size_t)(pq * 512 + g * GD + jg * 16 + i) * D + k0 + kk] = (bf16)f2bf(acc[i]);
    __syncthreads();
}
__device__ __forceinline__ void p1_phase(Frame& F) {
    for (int task = F.bid; task < 128; task += F.G) p1_fold_task(F, task);
    const int gw = F.bid * NWAVES + F.wave, NGW = F.G * NWAVES;
    for (int t = gw; t < TA; t += NGW) p1_row(F, t);
}

struct SchedInproj {
    int G, c; const char* hmod; const char* wint; char* px; char* pt;
    __device__ __forceinline__ bool next(int i, pg8::Unit& u) const {
        const int L = i * G + c;
        if (L < 720) { int pm, pn; pg8::tile_of(L, 72, 10, pm, pn);
            u.a = hmod + (size_t)pm * 256 * D * 2; u.b = wint + (size_t)pn * 256 * D * 2; u.o = px + ((size_t)pm * 256 * NPX + (size_t)pn * 256) * 2; u.i0 = NPX; u.i1 = u.i2 = u.i3 = 0; return true; }
        if (L < 976) { int pm, pn; pg8::tile_of(L - 720, 4, 64, pm, pn);
            const int pq = pm >> 1, c0 = (pm & 1) * 256, b = pn >> 3, l0 = (pn & 7) * 256;
            u.a = wint + (size_t)(NPX + pm * 256) * D * 2; u.b = hmod + (size_t)pn * 256 * D * 2;
            u.o = pt + ((((size_t)(pq * 8 + b) * 512 + c0) * SEQ) + l0) * 2; u.i0 = SEQ; u.i1 = u.i2 = u.i3 = 0; return true; }
        return false;
    }
};
__device__ __forceinline__ void p3_gla_chain(Frame& F, int chain) {
    const int vq = chain & 3, dir = (chain >> 2) & 1, h = (chain >> 3) & 3, b = chain >> 5;
    LAS float* qs = (LAS float*)F.lds;
    LAS float* fs = qs + 64 * 128;
    LAS float* vs = fs + 64 * 128;
    const bf16* px = (const bf16*)(F.ws + WS_PX);
    const float* lbp = (const float*)(F.ws + WS_LB) + dir * HW + h * HD;
    float* og = (float*)(F.ws + WS_OGLA) + (size_t)dir * T * HW;
    const int dkg = F.lane >> 2, vl = 4 * F.wave + (F.lane & 3);
    float S[8];
#pragma unroll
    for (int i = 0; i < 8; ++i) S[i] = 0.f;
    constexpr int NBLK = (CTX + SEQ) / 64;
    for (int blk = 0; blk < NBLK; ++blk) {
        const bool isctx = blk < CTX / 64;
        int tb;
        if (isctx) tb = (dir == 0) ? blk * 64 : (CTX - 64 - blk * 64);
        else { const int lb2 = blk - CTX / 64; tb = (dir == 0) ? lb2 * 64 : (SEQ - 64 - lb2 * 64); }
        const size_t rowbase = isctx ? (size_t)(T + b * CTX + tb) : (size_t)(b * SEQ + tb);
        __syncthreads();
        { const int r = F.tid >> 3, c16 = (F.tid & 7) * 16;
          const bf16* prow = px + (rowbase + r) * NPX;
          const v4u z0 = *(const v4u*)(prow + 3 * HW + dir * HW + h * HD + c16), z1 = *(const v4u*)(prow + 3 * HW + dir * HW + h * HD + c16 + 8);
          const unsigned zz[8] = {z0.x, z0.y, z0.z, z0.w, z1.x, z1.y, z1.z, z1.w};
#pragma unroll
          for (int u = 0; u < 8; ++u) { const float l0 = lbp[c16 + 2 * u], l1 = lbp[c16 + 2 * u + 1];
              fs[r * 128 + c16 + 2 * u] = l0 + (1.0f - l0) * sigmoidf_(bflo(zz[u])); fs[r * 128 + c16 + 2 * u + 1] = l1 + (1.0f - l1) * sigmoidf_(bfhi(zz[u])); }
          if (!isctx) { const v4u q0 = *(const v4u*)(prow + h * HD + c16), q1 = *(const v4u*)(prow + h * HD + c16 + 8);
              const unsigned qq[8] = {q0.x, q0.y, q0.z, q0.w, q1.x, q1.y, q1.z, q1.w};
#pragma unroll
              for (int u = 0; u < 8; ++u) { qs[r * 128 + c16 + 2 * u] = bflo(qq[u]); qs[r * 128 + c16 + 2 * u + 1] = bfhi(qq[u]); } }
          const int c4 = (F.tid & 7) * 4;
          const v2u vv = *(const v2u*)(prow + HW + h * HD + vq * 32 + c4);
          vs[r * 32 + c4] = bflo(vv.x); vs[r * 32 + c4 + 1] = bfhi(vv.x); vs[r * 32 + c4 + 2] = bflo(vv.y); vs[r * 32 + c4 + 3] = bfhi(vv.y); }
        __syncthreads();
        for (int s = 0; s < 64; ++s) {
            const int r = (dir == 0) ? s : 63 - s;
            const f32x4 f0 = *(const LAS f32x4*)(fs + r * 128 + dkg * 8), f1 = *(const LAS f32x4*)(fs + r * 128 + dkg * 8 + 4);
            const float v = vs[r * 32 + vl];
            const float ff[8] = {f0.x, f0.y, f0.z, f0.w, f1.x, f1.y, f1.z, f1.w};
#pragma unroll
            for (int i = 0; i < 8; ++i) S[i] = fmaf(ff[i], S[i], fmaf(-ff[i], v, v));
            if (!isctx) {
                const f32x4 q0 = *(const LAS f32x4*)(qs + r * 128 + dkg * 8), q1 = *(const LAS f32x4*)(qs + r * 128 + dkg * 8 + 4);
                float o = q0.x * S[0] + q0.y * S[1] + q0.z * S[2] + q0.w * S[3] + q1.x * S[4] + q1.y * S[5] + q1.z * S[6] + q1.w * S[7];
                o += __shfl_xor(o, 4); o += __shfl_xor(o, 8); o += __shfl_xor(o, 16); o += __shfl_xor(o, 32);
                if (F.lane < 4) og[(rowbase + r) * HW + h * HD + vq * 32 + vl] = o;
            }
        }
    }
    __syncthreads();
}
struct SchedFourier {
    int G, c; const char* dft; const char* pt; char* eo;
    __device__ __forceinline__ bool next(int i, pg8::Unit& u) const {
        const int L = i * G + c; if (L >= 256) return false;
        const int b = L & 7, r = L >> 3, kt = r >> 2, pn = r & 3, pq = pn >> 1;
        u.a = dft + ((size_t)pq * SEQ * SEQ + (size_t)kt * 256 * SEQ) * 2;
        u.b = pt + (((size_t)(pq * 8 + b) * 512 + (pn & 1) * 256) * SEQ) * 2;
        u.o = eo + (((size_t)b * SEQ + kt * 256) * D + pn * 256) * 2; u.i0 = D; u.i1 = u.i2 = u.i3 = 0; return true;
    }
};
__device__ __forceinline__ void p3c_row(Frame& F, int t) {
    const float* o0 = (const float*)(F.ws + WS_OGLA) + (size_t)t * HW + 8 * F.lane; const float* o1 = o0 + (size_t)T * HW;
    const f32x4 a0 = *(const f32x4*)o0, a1 = *(const f32x4*)(o0 + 4), b0 = *(const f32x4*)o1, b1 = *(const f32x4*)(o1 + 4);
    float o[8] = {a0.x + b0.x, a0.y + b0.y, a0.z + b0.z, a0.w + b0.w, a1.x + b1.x, a1.y + b1.y, a1.z + b1.z, a1.w + b1.w};
    float ss = 0.f;
#pragma unroll
    for (int i = 0; i < 8; ++i) ss += o[i] * o[i];
    ss += __shfl_xor(ss, 1); ss += __shfl_xor(ss, 2); ss += __shfl_xor(ss, 4); ss += __shfl_xor(ss, 8);
    const float rinv = 1.0f / sqrtf(ss * (1.0f / HD) + NORM_EPS);
    const float* gn = F.in[I_GN] + ((8 * F.lane) & 127);
    const v4u gz = *(const v4u*)((const bf16*)(F.ws + WS_PX) + (size_t)t * NPX + 2 * HW + 8 * F.lane);
    const unsigned gg[4] = {gz.x, gz.y, gz.z, gz.w};
    float hx[8];
#pragma unroll
    for (int u = 0; u < 4; ++u) { hx[2 * u] = o[2 * u] * rinv * gn[2 * u] * sigmoidf_(bflo(gg[u])); hx[2 * u + 1] = o[2 * u + 1] * rinv * gn[2 * u + 1] * sigmoidf_(bfhi(gg[u])); }
    bf16* mix = (bf16*)(F.ws + WS_MIX) + (size_t)t * D;
    v4u w; w.x = pk2(hx[0], hx[1]); w.y = pk2(hx[2], hx[3]); w.z = pk2(hx[4], hx[5]); w.w = pk2(hx[6], hx[7]);
    *(v4u*)(mix + 8 * F.lane) = w;
    const bf16* eo = (const bf16*)(F.ws + WS_EO) + (size_t)t * D + 8 * F.lane;
    const v4u e = *(const v4u*)eo, q = *(const v4u*)(eo + 512);
    v4u f; f.x = pk2(bflo(e.x) - bflo(q.x), bfhi(e.x) - bfhi(q.x)); f.y = pk2(bflo(e.y) - bflo(q.y), bfhi(e.y) - bfhi(q.y));
    f.z = pk2(bflo(e.z) - bflo(q.z), bfhi(e.z) - bfhi(q.z)); f.w = pk2(bflo(e.w) - bflo(q.w), bfhi(e.w) - bfhi(q.w));
    *(v4u*)(mix + HW + 8 * F.lane) = f;
}
struct SchedWout {
    int G, c; const char* mix; const char* wout;
    __device__ __forceinline__ bool next(int i, pg8::Unit& u) const {
        const int L = i * G + c; if (L >= 256) return false;
        int pm, pn; pg8::tile_of(L, 64, 4, pm, pn);
        u.a = mix + (size_t)pm * 256 * D * 2; u.b = wout + (size_t)pn * 256 * D * 2; u.o = nullptr; u.i0 = pm * 256; u.i1 = pn * 256; u.i2 = u.i3 = 0; return true;
    }
};
__device__ __forceinline__ void p5a_phase(Frame& F) {
    LAS float* wrT = (LAS float*)F.lds;
    volatile LAS unsigned* lcnt = F.MISC + 16;
    volatile LAS unsigned* lbase = F.MISC + 48;
    const float* rw = F.in[I_RW];
    for (int i = F.tid; i < D * NE; i += NTHR) { const int k = i >> 5, e = i & 31; wrT[e * 1024 + k] = rw[i]; }
    const float* mod = (const float*)(F.ws + WS_MOD); const float* g2 = F.in[I_N2G];
    int* tok_e = (int*)(F.ws + WS_ROUTE); int* tok_pos = tok_e + T * 4; float* tok_w = (float*)(tok_pos + T * 4);
    for (int base = F.bid * 64; base < T; base += F.G * 64) {
        if (F.tid < 32) lcnt[F.tid] = 0u;
        __syncthreads();
        int my_e = 0; unsigned my_rank = 0; float my_w = 0.f;
#pragma unroll 1
        for (int i = 0; i < 8; ++i) {
            const int t = base + F.wave * 8 + i; const int b = t >> 11;
            const GAS f32x4* xr = (const GAS f32x4*)((const float*)(F.ws + WS_X2) + (size_t)t * D) + F.lane;
            f32x4 v[4]; float ss = 0.f;
#pragma unroll
            for (int j = 0; j < 4; ++j) { v[j] = xr[64 * j]; ss += (v[j].x * v[j].x + v[j].y * v[j].y) + (v[j].z * v[j].z + v[j].w * v[j].w); }
            const float rinv = 1.0f / sqrtf(wave_sum(ss) * (1.0f / D) + NORM_EPS);
            GAS unsigned long long* o8 = (GAS unsigned long long*)((bf16*)(F.ws + WS_HM) + (size_t)t * D) + F.lane;
#pragma unroll
            for (int j = 0; j < 4; ++j) { const int c = 4 * F.lane + 256 * j;
                const f32x4 g = *(const f32x4*)(g2 + c), sh = *(const f32x4*)(mod + b * 6144 + 3 * D + c), sc = *(const f32x4*)(mod + b * 6144 + 4 * D + c);
                v[j] = v[j] * rinv * g * (sc + 1.0f) + sh;
                o8[64 * j] = (unsigned long long)pk2(v[j].x, v[j].y) | ((unsigned long long)pk2(v[j].z, v[j].w) << 32); }
            float acc[32];
#pragma unroll
            for (int e = 0; e < 32; ++e) { float a = 0.f;
                if ((e & 3) == 0) asm volatile("" ::: "memory");
#pragma unroll
                for (int j = 0; j < 4; ++j) { const f32x4 w = *(const LAS f32x4*)(wrT + e * 1024 + 4 * F.lane + 256 * j); a += v[j].x * w.x + v[j].y * w.y + v[j].z * w.z + v[j].w * w.w; }
                acc[e] = a; }
#define P5_HALVE(N, MASK) _Pragma("unroll") for (int j = 0; j < N; ++j) { const bool hi = (F.lane & MASK) != 0; const float keep = hi ? acc[j + N] : acc[j]; const float send = hi ? acc[j] : acc[j + N]; acc[j] = keep + __shfl_xor(send, MASK); }
            P5_HALVE(16, 32) P5_HALVE(8, 16) P5_HALVE(4, 8) P5_HALVE(2, 4) P5_HALVE(1, 2)
#undef P5_HALVE
            float lg = acc[0] + __shfl_xor(acc[0], 1);
            const int e_me = F.lane >> 1;
            lg += F.in[I_RB][e_me];
            float tv0, tv1, tv2, tv3; int te0, te1, te2, te3;
#define P5_TOP(TV, TE) { const float m = wave_max(lg); const unsigned long long bal = __ballot(lg == m); const int ln = __ffsll((long long)bal) - 1; TE = ln >> 1; TV = m; if (e_me == TE) lg = -3.0e38f; }
            P5_TOP(tv0, te0) P5_TOP(tv1, te1) P5_TOP(tv2, te2) P5_TOP(tv3, te3)
#undef P5_TOP
            const float e1 = __expf(tv1 - tv0), e2 = __expf(tv2 - tv0), e3 = __expf(tv3 - tv0); const float inv = 1.0f / (1.0f + e1 + e2 + e3);
            if ((F.lane >> 2) == i && F.lane < 32) { const int k = F.lane & 3; my_e = te0; my_w = inv;
                if (k == 1) { my_e = te1; my_w = e1 * inv; } if (k == 2) { my_e = te2; my_w = e2 * inv; } if (k == 3) { my_e = te3; my_w = e3 * inv; } }
        }
        if (F.lane < 32) my_rank = __hip_atomic_fetch_add((LAS unsigned*)lcnt + my_e, 1u, __ATOMIC_RELAXED, __HIP_MEMORY_SCOPE_WORKGROUP);
        __syncthreads();
        if (F.tid < 32) lbase[F.tid] = __hip_atomic_fetch_add((unsigned*)(F.ctl + CW_CNT) + F.tid, lcnt[F.tid], __ATOMIC_RELAXED, __HIP_MEMORY_SCOPE_AGENT);
        __syncthreads();
        if (F.lane < 32) { const int t = base + F.wave * 8 + (F.lane >> 2); const int idx = t * 4 + (F.lane & 3);
            tok_e[idx] = my_e; tok_pos[idx] = (int)(lbase[my_e] + my_rank); tok_w[idx] = my_w; }
        __syncthreads();
    }
}
__device__ __forceinline__ void moe_offsets(Frame& F, volatile LAS unsigned* boff) {
    if (F.tid == 0) { unsigned acc = 0; for (int e = 0; e < NE; ++e) { boff[e] = acc; acc += (((const unsigned*)(F.ctl + CW_CNT))[e] + 255u) >> 8; } boff[NE] = acc; }
    __syncthreads();
}
__device__ __forceinline__ void p5c_phase(Frame& F) {
    volatile LAS unsigned* boff = F.MISC + 16;
    moe_offsets(F, boff);
    const int* tok_e = (const int*)(F.ws + WS_ROUTE); const int* tok_pos = tok_e + T * 4; int* tok_slot = (int*)(F.ws + WS_ROUTE) + 3 * T * 4;
    const int gw = F.bid * NWAVES + F.wave, NGW = F.G * NWAVES;
    for (int t = gw; t < T; t += NGW) {
        const GAS v4u* src = (const GAS v4u*)((const bf16*)(F.ws + WS_HM) + (size_t)t * D) + F.lane;
        const v4u r0 = src[0], r1 = src[64];
#pragma unroll
        for (int k = 0; k < 4; ++k) { const int e = tok_e[t * 4 + k]; const int slot = (int)(boff[e] * 256u) + tok_pos[t * 4 + k];
            GAS v4u* dst = (GAS v4u*)((bf16*)(F.ws + WS_HMP) + (size_t)slot * D) + F.lane; dst[0] = r0; dst[64] = r1;
            if (F.lane == 0) tok_slot[t * 4 + k] = slot; }
    }
}
template <int NPN, int MODE>
struct SchedMoe {
    int r, nmem, x; unsigned n0, n1, n2, n3, b0, b1, b2, b3; const char* A; const char* B;
    __device__ __forceinline__ void init(Frame& F, volatile LAS unsigned* boff, const char* A_, const char* B_) {
        x = F.bid & 7; r = F.bid >> 3; nmem = (F.G + 7 - x) / 8; A = A_; B = B_;
        b0 = boff[x]; n0 = boff[x + 1] - b0; b1 = boff[x + 8]; n1 = boff[x + 9] - b1; b2 = boff[x + 16]; n2 = boff[x + 17] - b2; b3 = boff[x + 24]; n3 = boff[x + 25] - b3;
        if ((F.G & 7) != 0) { nmem = 0; }
    }
    __device__ __forceinline__ bool next(int i, pg8::Unit& u) const {
        if (nmem == 0) return false;
        const unsigned j = (unsigned)(i * nmem + r); unsigned blk = j / NPN; const int pn = (int)(j % NPN);
        int e; unsigned gb;
        if (blk < n0) { e = x; gb = b0 + blk; }
        else { blk -= n0;
            if (blk < n1) { e = x + 8; gb = b1 + blk; }
            else { blk -= n1;
                if (blk < n2) { e = x + 16; gb = b2 + blk; }
                else { blk -= n2; if (blk >= n3) return false; e = x + 24; gb = b3 + blk; } } }
        u.a = A + (size_t)gb * 256 * D * 2;
        if (MODE == 1) u.b = B + ((size_t)e * 2 * DFF + (size_t)pn * 128) * D * 2; else u.b = B + ((size_t)e * D + (size_t)pn * 256) * DFF * 2;
        u.o = nullptr; u.i0 = (int)gb * 256; u.i1 = pn; u.i2 = e; u.i3 = 0; return true;
    }
};
__device__ __forceinline__ void p8_row(Frame& F, int t) {
    const int b = t >> 11; const float* mod = (const float*)(F.ws + WS_MOD);
    const int* tok_slot = (const int*)(F.ws + WS_ROUTE) + 3 * T * 4; const float* tok_w = (const float*)(F.ws + WS_ROUTE) + 2 * T * 4;
    const GAS f32x4* xr = (const GAS f32x4*)((const float*)(F.ws + WS_X2) + (size_t)t * D) + F.lane;
    f32x4 v[4], m[4];
#pragma unroll
    for (int j = 0; j < 4; ++j) { v[j] = xr[64 * j]; m[j] = (f32x4){0.f, 0.f, 0.f, 0.f}; }
#pragma unroll
    for (int k = 0; k < 4; ++k) { const int slot = tok_slot[t * 4 + k]; const float w = tok_w[t * 4 + k];
        const GAS v2u* yr = (const GAS v2u*)((const bf16*)(F.ws + WS_YS) + (size_t)slot * D) + F.lane;
#pragma unroll
        for (int j = 0; j < 4; ++j) { const v2u y = yr[64 * j]; m[j].x += w * bflo(y.x); m[j].y += w * bfhi(y.x); m[j].z += w * bflo(y.y); m[j].w += w * bfhi(y.y); } }
    float ss = 0.f;
#pragma unroll
    for (int j = 0; j < 4; ++j) { const f32x4 g = *(const f32x4*)(mod + b * 6144 + 5 * D + 4 * F.lane + 256 * j); v[j] = v[j] + g * m[j];
        ss += (v[j].x * v[j].x + v[j].y * v[j].y) + (v[j].z * v[j].z + v[j].w * v[j].w); }
    const float rinv = 1.0f / sqrtf(wave_sum(ss) * (1.0f / D) + NORM_EPS);
    GAS f32x4* orow = (GAS f32x4*)(F.out + (size_t)t * D) + F.lane;
#pragma unroll
    for (int j = 0; j < 4; ++j) { const f32x4 g = *(const f32x4*)(F.in[I_FG] + 4 * F.lane + 256 * j); orow[64 * j] = v[j] * rinv * g; }
}

constexpr int N_PHASES = 11;
struct Args { const float* in[20]; float* out; unsigned char* ws; int ph_lo, ph_hi; };
__global__ void __launch_bounds__(NTHR, 2) fwd_kernel(Args args) {
    extern __shared__ __attribute__((aligned(16))) unsigned char lds[];
    Frame F;
    F.lds = (LAS unsigned char*)lds; F.MISC = (volatile LAS unsigned*)(F.lds + MISC_OFF);
    F.tid = threadIdx.x; F.lane = F.tid & 63; F.wave = __builtin_amdgcn_readfirstlane(F.tid >> 6);
    F.G = gridDim.x; F.bid = blockIdx.x;
#pragma unroll
    for (int i = 0; i < 20; ++i) F.in[i] = args.in[i];
    F.out = args.out; F.ws = args.ws; F.ctl = (gu32*)(args.ws + WS_CTL);
    for (int u = F.tid; u < (LDS_BYTES - LDSCTL_OFF) / 4; u += NTHR) ((LAS unsigned*)(F.lds + LDSCTL_OFF))[u] = 0u;
    __syncthreads();
    const int lo = args.ph_lo, hi = args.ph_hi;
    const bool multi = (hi - lo) > 1;
    XcdBarrier bar; bar.bar = (unsigned*)(F.ctl + CW_BAR); bar.x = 0; bar.st = nullptr;
    if (multi) bar = xcd_barrier_post((unsigned*)(F.ctl + CW_BAR), F.MISC + 8);
#define IN(k) (lo <= (k) && (k) < hi)
#define SEAM(k) do { if (IN(k) && IN((k) + 1)) xcd_barrier(bar); } while (0)
    const int gw = F.bid * NWAVES + F.wave, NGW = F.G * NWAVES;

    if (IN(0)) { p0_prologue(F); }
    SEAM(0);
    if (IN(1)) { p1_phase(F); }
    SEAM(1);
    if (IN(2)) {
        SchedInproj S{F.G, F.bid, (const char*)(F.ws + WS_HMOD), (const char*)(F.ws + WS_WINT), (char*)(F.ws + WS_PX), (char*)(F.ws + WS_PT)};
        pg8::EpiStoreBf16 E;
        pg8::gemm_phase(F.lds, D, (size_t)128 * D * 2, (size_t)128 * D * 2, S, E);
    }
    SEAM(2);
    if (IN(3)) {
        for (int ch = F.bid; ch < 256; ch += F.G) p3_gla_chain(F, ch);
        SchedFourier S{F.G, F.bid, (const char*)(F.ws + WS_DFT), (const char*)(F.ws + WS_PT), (char*)(F.ws + WS_EO)};
        pg8::EpiStoreBf16 E;
        pg8::gemm_phase(F.lds, SEQ, (size_t)128 * SEQ * 2, (size_t)128 * SEQ * 2, S, E);
    }
    SEAM(3);
    if (IN(4)) { for (int t = gw; t < T; t += NGW) p3c_row(F, t); }
    SEAM(4);
    if (IN(5)) {
        SchedWout S{F.G, F.bid, (const char*)(F.ws + WS_MIX), (const char*)(F.ws + WS_WOUT)};
        pg8::EpiWout E{F.in[I_X], (const float*)(F.ws + WS_POS), (const float*)(F.ws + WS_MOD), (float*)(F.ws + WS_X2)};
        pg8::gemm_phase(F.lds, D, (size_t)128 * D * 2, (size_t)128 * D * 2, S, E);
    }
    SEAM(5);
    if (IN(6)) { p5a_phase(F); }
    SEAM(6);
    if (IN(7)) { p5c_phase(F); }
    SEAM(7);
    if (IN(8)) {
        volatile LAS unsigned* boff = F.MISC + 16; moe_offsets(F, boff);
        SchedMoe<8, 1> S; S.init(F, boff, (const char*)(F.ws + WS_HMP), (const char*)(F.ws + WS_WB1));
        pg8::EpiMoe1 E{F.in[I_B1], (bf16*)(F.ws + WS_HH)};
        pg8::gemm_phase(F.lds, D, (size_t)128 * D * 2, (size_t)DFF * D * 2, S, E);
    }
    SEAM(8);
    if (IN(9)) {
        volatile LAS unsigned* boff = F.MISC + 16; moe_offsets(F, boff);
        SchedMoe<4, 2> S; S.init(F, boff, (const char*)(F.ws + WS_HH), (const char*)(F.ws + WS_WB2));
        pg8::EpiMoe2 E{F.in[I_B2], (bf16*)(F.ws + WS_YS)};
        pg8::gemm_phase(F.lds, DFF, (size_t)128 * DFF * 2, (size_t)128 * DFF * 2, S, E);
    }
    SEAM(9);
    if (IN(10)) { for (int t = gw; t < T; t += NGW) p8_row(F, t); }
#undef IN
#undef SEAM
}

extern "C" void kernel_launch(void* const* d_in, const int* in_sizes, int n_in, void* d_out, int out_size, void* d_ws, size_t ws_size, hipStream_t stream) {
    static int grid = 0;
    if (grid == 0) {
        if (n_in != 20 || out_size != T * D || ws_size < WS_END) { fprintf(stderr, "kernel_launch: unexpected shapes (n_in %d out %d ws %zu need %zu)\n", n_in, out_size, ws_size, (size_t)WS_END); grid = -1; return; }
        int dev = 0, cus = 0, per_cu = 0;
        if (hipGetDevice(&dev) != hipSuccess || hipDeviceGetAttribute(&cus, hipDeviceAttributeMultiprocessorCount, dev) != hipSuccess) { grid = -1; return; }
        if (hipFuncSetAttribute((const void*)fwd_kernel, hipFuncAttributeMaxDynamicSharedMemorySize, LDS_BYTES) != hipSuccess) { fprintf(stderr, "kernel_launch: hipFuncSetAttribute failed\n"); grid = -1; return; }
        if (hipOccupancyMaxActiveBlocksPerMultiprocessor(&per_cu, (const void*)fwd_kernel, NTHR, LDS_BYTES) != hipSuccess || per_cu < 1) { fprintf(stderr, "kernel_launch: occupancy query says %d\n", per_cu); }
        (void)hipGetLastError();
        grid = cus;
    }
    if (grid < 0) return;
    if (hipMemsetAsync((char*)d_ws + WS_CTL, 0, CTL_ZERO_BYTES, stream) != hipSuccess) return;
    Args a{};
    for (int i = 0; i < 20; ++i) a.in[i] = (const float*)d_in[i];
    a.out = (float*)d_out; a.ws = (unsigned char*)d_ws;
#if MK_N_LAUNCHES == 1
    a.ph_lo = 0; a.ph_hi = N_PHASES;
    hipLaunchKernelGGL(fwd_kernel, dim3(grid), dim3(NTHR), LDS_BYTES, stream, a);
#else
    for (int p = 0; p < N_PHASES; ++p) { a.ph_lo = p; a.ph_hi = p + 1; hipLaunchKernelGGL(fwd_kernel, dim3(grid), dim3(NTHR), LDS_BYTES, stream, a); }
#endif
}
```

```cpp
#include <hip/hip_runtime.h>
#include <cstdio>
#include <cstdint>

#ifndef PROBE_PHASE
#define PROBE_PHASE (-1)
#define PROBE_REPS 2
#endif
#ifndef MK_N_LAUNCHES
#define MK_N_LAUNCHES 1
#endif

#define GAS __attribute__((address_space(1)))
#define LAS __attribute__((address_space(3)))
typedef unsigned short bf16;
typedef unsigned v4u __attribute__((ext_vector_type(4)));
typedef unsigned v2u __attribute__((ext_vector_type(2)));
typedef float f32x4 __attribute__((ext_vector_type(4)));
typedef float f32x2 __attribute__((ext_vector_type(2)));
typedef short bf16x8 __attribute__((ext_vector_type(8)));
typedef GAS unsigned gu32;

constexpr int D = 1024, NB = 8, SEQ = 2048, T = NB * SEQ, CTX = 256, TC = NB * CTX, TA = T + TC;
constexpr int HW = 512, HD = 128, NH = 4, FWID = 512, NG = 4, GD = 128;
constexpr int NPX = 5 * HW;
constexpr int NE = 32, TOPK = 4, DFF = 1024;
constexpr int SLOT_MAX = T * TOPK + NE * 256;
constexpr float NORM_EPS = 1e-6f;
constexpr int NWAVES = 8, NTHR = 512;

constexpr size_t MiB = 1u << 20;
constexpr size_t WS_CTL = 0, CTL_ZERO_BYTES = 1 * MiB;
constexpr size_t WS_MOD = 1 * MiB;
constexpr size_t WS_LB = WS_MOD + 9 * 6144 * 4;
constexpr size_t WS_ROUTE = WS_LB + 4096;
constexpr size_t WS_MG = 3 * MiB;
constexpr size_t WS_POS = 4 * MiB;
constexpr size_t WS_WINT = 12 * MiB;
constexpr size_t WS_WOUT = 19 * MiB;
constexpr size_t WS_DFT = 21 * MiB;
constexpr size_t WS_WB1 = 37 * MiB;
constexpr size_t WS_WB2 = 165 * MiB;
constexpr size_t WS_HMOD = 229 * MiB;
constexpr size_t WS_R1 = 265 * MiB;
constexpr size_t WS_PX = WS_R1;
constexpr size_t WS_PT = WS_PX + 90 * MiB;
constexpr size_t WS_OGLA = WS_PT + 32 * MiB;
constexpr size_t WS_EO = WS_OGLA + 64 * MiB;
constexpr size_t WS_HMP = WS_R1;
constexpr size_t WS_YS = WS_R1;
constexpr size_t WS_MIX = WS_R1 + 218 * MiB;
constexpr size_t WS_X2 = WS_MIX + 32 * MiB;
constexpr size_t WS_HM = WS_X2 + 64 * MiB;
constexpr size_t WS_HH = WS_HM + 32 * MiB;
constexpr size_t WS_END = WS_HH + 144 * MiB;
static_assert(WS_END <= 1024 * MiB, "workspace map");
constexpr int CW_CNT0 = 64;
#define CW_CNT (CW_CNT0 + ((PROBE_PHASE == 6) ? 32 * (PROBE_REPS - 1) : 0))
constexpr int CW_BAR = 4096;

constexpr int RING_BYTES = 131072;
constexpr int LDSCTL_OFF = RING_BYTES, MISC_OFF = LDSCTL_OFF + 320;
constexpr int LDS_BYTES = 147456;

#define LDS_WAIT() asm volatile("s_waitcnt lgkmcnt(0)" ::: "memory")
#define VM_WAIT() asm volatile("s_waitcnt vmcnt(0)" ::: "memory")
__device__ __forceinline__ unsigned f2bf(float f) { unsigned u = __builtin_bit_cast(unsigned, f); return (u + 0x7fffu + ((u >> 16) & 1u)) >> 16; }
__device__ __forceinline__ unsigned pk2(float lo, float hi) { return f2bf(lo) | (f2bf(hi) << 16); }
__device__ __forceinline__ float bf2f(unsigned short b) { return __builtin_bit_cast(float, ((unsigned)b) << 16); }
__device__ __forceinline__ float bflo(unsigned u) { return __builtin_bit_cast(float, u << 16); }
__device__ __forceinline__ float bfhi(unsigned u) { return __builtin_bit_cast(float, u & 0xffff0000u); }
__device__ __forceinline__ float sigmoidf_(float x) { return __builtin_amdgcn_rcpf(1.0f + __expf(-x)); }

#define XB_TMO      128
#define XB_XCNT(j)  (256  + 64 * (j))
#define XB_XSUB(j)  (1280 + 64 * (j))
#define XB_XGEN(j)  (2304 + 64 * (j))
#define XB_TOP      3328
#define XB_TOPGEN   3392
#define XCD_BAR_WORDS 3456
#define XB_SPIN_CAP (1u << 18)
__device__ __forceinline__ unsigned xb_ld(unsigned* p)              { return __hip_atomic_load(p, __ATOMIC_RELAXED, __HIP_MEMORY_SCOPE_AGENT); }
__device__ __forceinline__ unsigned xb_add(unsigned* p, unsigned v) { return __hip_atomic_fetch_add(p, v, __ATOMIC_RELAXED, __HIP_MEMORY_SCOPE_AGENT); }
__device__ __forceinline__ unsigned xb_xcc_id() { return (unsigned)__builtin_amdgcn_s_getreg((3 << 11) | 20) & 0xFu; }
#define XB_SPIN(cond, bar) do { unsigned _sp = 0; while (cond) { __builtin_amdgcn_s_sleep(1); \
    if ((++_sp & 255u) == 0u) { if (xb_ld(&(bar)[XB_TMO])) break; if (_sp > XB_SPIN_CAP) { atomicAdd(&(bar)[XB_TMO], 1u); break; } } } } while (0)
struct XcdBarrier { unsigned* bar; unsigned x; volatile LAS unsigned* st; };
__device__ __forceinline__ XcdBarrier xcd_barrier_post(unsigned* bar, volatile LAS unsigned* st) {
    XcdBarrier b; b.bar = bar; b.x = xb_xcc_id(); b.st = st;
    if (threadIdx.x == 0) (void)xb_add(&bar[XB_XCNT(b.x)], 1u);
    return b;
}
__device__ __forceinline__ void xcd_barrier_complete(unsigned* bar, unsigned x, unsigned& nloc, unsigned& nx) {
    const unsigned G = gridDim.x * gridDim.y * gridDim.z;
    unsigned sum, cnt, mine, sp = 0u;
    for (;;) {
        sum = 0u; cnt = 0u; mine = 0u;
#pragma unroll
        for (unsigned j = 0; j < 16; ++j) { const unsigned c = xb_ld(&bar[XB_XCNT(j)]); sum += c; cnt += (c > 0u) ? 1u : 0u; mine = (j == x) ? c : mine; }
        if (sum == G) break;
        __builtin_amdgcn_s_sleep(1);
        if ((++sp & 255u) == 0u) { if (xb_ld(&bar[XB_TMO])) break; if (sp > XB_SPIN_CAP) { atomicAdd(&bar[XB_TMO], 1u); break; } }
    }
    nloc = mine > 0u ? mine : 1u; nx = cnt > 0u ? cnt : 1u;
}
__device__ __forceinline__ void xcd_barrier(const XcdBarrier& b) {
    asm volatile("s_waitcnt vmcnt(0)" ::: "memory");
    __syncthreads();
    if (threadIdx.x == 0) {
        unsigned* bar = b.bar;
        __builtin_amdgcn_s_waitcnt(0);
        unsigned nloc = b.st[0], nx = b.st[1];
        if (nloc == 0u) { xcd_barrier_complete(bar, b.x, nloc, nx); b.st[0] = nloc; b.st[1] = nx; }
        const unsigned old = xb_add(&bar[XB_XSUB(b.x)], 1u);
        const unsigned gen = old / nloc;
        if (old + 1u == (gen + 1u) * nloc) {
            __builtin_amdgcn_fence(__ATOMIC_RELEASE, "agent");
            asm volatile("s_waitcnt vmcnt(0)" ::: "memory");
            const unsigned og = xb_add(&bar[XB_TOP], 1u);
            const unsigned tg = og / nx;
            if (og + 1u == (tg + 1u) * nx) xb_add(&bar[XB_TOPGEN], 1u);
            else XB_SPIN(xb_ld(&bar[XB_TOPGEN]) == tg, bar);
            __builtin_amdgcn_fence(__ATOMIC_ACQUIRE, "agent");
            xb_add(&bar[XB_XGEN(b.x)], 1u);
            asm volatile("s_waitcnt vmcnt(0)" ::: "memory");
        } else {
            XB_SPIN(xb_ld(&bar[XB_XGEN(b.x)]) == gen, bar);
            __builtin_amdgcn_fence(__ATOMIC_ACQUIRE, "agent");
            asm volatile("s_waitcnt vmcnt(0)" ::: "memory");
        }
    }
    __syncthreads();
}

namespace pg8 {
constexpr int BM = 256, BK = 64, HALF = 128, HTB = HALF * BK * 2, NXCD = 8, WGM = 8;
__host__ __device__ __forceinline__ int lds_byte(int r, int c) { const int st = (r >> 4) * 2 + (c >> 5), rr = r & 15, cc = c & 31, ob = rr * 64 + cc * 2; return st * 1024 + (ob ^ (((ob >> 9) & 1) << 5)); }
__host__ __device__ __forceinline__ void stage_rc(int b, int& R, int& C) { const int st = b / 1024, sb = b % 1024, swz = sb ^ (((sb >> 9) & 1) << 5); R = (st >> 1) * 16 + swz / 64; C = (st & 1) * 32 + (swz % 64) / 2; }
__host__ __device__ __forceinline__ int perm32(int rho) { const int n = rho >> 4, i = rho & 15; return 8 * (i >> 2) + 4 * n + (i & 3); }

struct Unit { const char* a; const char* b; char* o; int i0, i1, i2, i3; };

__device__ __forceinline__ void tile_of(int L, int nM, int nN, int& pm, int& pn) {
    const int nwg = nM * nN; int wgid = L;
    { const int q = nwg / NXCD, r = nwg % NXCD, xcd = wgid % NXCD, off = wgid / NXCD; wgid = (xcd < r ? xcd * (q + 1) : r * (q + 1) + (xcd - r) * q) + off; }
    const int nig = WGM * nN, gid = wgid / nig, fm = gid * WGM, gsz = (nM - fm) < WGM ? (nM - fm) : WGM;
    pm = fm + ((wgid % nig) % gsz); pn = (wgid % nig) / gsz;
}
__device__ __forceinline__ unsigned cvt_pk_bf16(float lo, float hi) { unsigned r; asm volatile("v_cvt_pk_bf16_f32 %0, %1, %2" : "=v"(r) : "v"(lo), "v"(hi)); return r; }

template <class Epi, class Sched>
__device__ __forceinline__ void gemm_phase(LAS unsigned char* lds, const int K, const size_t hsA, const size_t hsB, const Sched& S, const Epi& E) {
    const int tid = threadIdx.x, wid = __builtin_amdgcn_readfirstlane(tid >> 6), lane = tid & 63, wr = wid >> 2, wc = wid & 3, fr = lane & 15, fq = lane >> 4;
    const int nt = K / BK;
    unsigned voffA[2], voffB[2];
#pragma unroll
    for (int i = 0; i < 2; ++i) { int R, C; stage_rc(tid * 16 + i * 8192, R, C); const int Rb = Epi::PERM ? ((R & ~31) + perm32(R & 31)) : R;
        voffA[i] = (unsigned)(R * K + C) * 2u; voffB[i] = (unsigned)(Rb * K + C) * 2u; }
    const size_t kstep = (size_t)(BK * 2);
    const unsigned ldsw = (unsigned)wid * 1024u;
    const int aoff = lds_byte(wr * 64 + fr, fq * 8), boff = lds_byte(wc * 32 + fr, fq * 8);
#define PG8_SA(b, h) (((b) * 2 + (h)) * HTB)
#define PG8_SB(b, h) ((4 + (b) * 2 + (h)) * HTB)
#define PG8_STAGE(bufoff, gbase, voff) do { _Pragma("unroll") for (int _i = 0; _i < 2; ++_i) \
        __builtin_amdgcn_global_load_lds((const unsigned*)((const char*)(gbase) + (voff)[_i]), (LAS unsigned*)(lds + (bufoff) + ldsw + _i * 8192), 16, 0, 0); } while (0)
#define PG8_LDA(dst, b, h) do { _Pragma("unroll") for (int m = 0; m < 4; ++m) _Pragma("unroll") for (int k = 0; k < 2; ++k) dst[m][k] = *(const LAS bf16x8*)(lds + PG8_SA(b, h) + aoff + m * 2048 + k * 1024); } while (0)
#define PG8_LDB(dst, b, h) do { _Pragma("unroll") for (int n = 0; n < 2; ++n) _Pragma("unroll") for (int k = 0; k < 2; ++k) dst[n][k] = *(const LAS bf16x8*)(lds + PG8_SB(b, h) + boff + n * 2048 + k * 1024); } while (0)
#define PG8_MMA(ai, bj, At, Bt) do { __builtin_amdgcn_s_setprio(1); _Pragma("unroll") for (int m = 0; m < 4; ++m) _Pragma("unroll") for (int n = 0; n < 2; ++n) _Pragma("unroll") for (int k = 0; k < 2; ++k) \
        acc[ai][bj][m][n] = __builtin_amdgcn_mfma_f32_16x16x32_bf16(Bt[n][k], At[m][k], acc[ai][bj][m][n], 0, 0, 0); __builtin_amdgcn_s_setprio(0); } while (0)
#define PG8_WAIT_V(n) asm volatile("s_waitcnt vmcnt(" #n ")" ::: "memory")
#define PG8_WAIT_L(n) asm volatile("s_waitcnt lgkmcnt(" #n ")" ::: "memory")
#define PG8_BAR __builtin_amdgcn_s_barrier()
#define PG8_SCHED __builtin_amdgcn_sched_barrier(0)
    Unit cur, nxt; int ui = 0;
    if (!S.next(0, cur)) return;
    f32x4 acc[2][2][4][2];
#pragma unroll
    for (int a = 0; a < 2; ++a)
#pragma unroll
        for (int b = 0; b < 2; ++b)
#pragma unroll
            for (int m = 0; m < 4; ++m)
#pragma unroll
                for (int n = 0; n < 2; ++n) acc[a][b][m][n] = (f32x4){0.f, 0.f, 0.f, 0.f};
    bf16x8 At[4][2], B0[2][2], B1[2][2];
    const char* cA = cur.a; const char* cB = cur.b;
    PG8_STAGE(PG8_SB(0, 0), cB, voffB); PG8_STAGE(PG8_SB(0, 1), cB + hsB, voffB); PG8_STAGE(PG8_SA(0, 0), cA, voffA); PG8_STAGE(PG8_SA(0, 1), cA + hsA, voffA);
    if (wr == 1) PG8_BAR;
    PG8_WAIT_V(2); PG8_BAR;
    PG8_STAGE(PG8_SB(1, 0), cB + kstep, voffB); PG8_STAGE(PG8_SA(1, 0), cA + kstep, voffA); PG8_STAGE(PG8_SB(1, 1), cB + hsB + kstep, voffB);
    PG8_WAIT_V(6); PG8_BAR;
    for (;;) {
        const bool has_next = S.next(ui + 1, nxt);
        const char* nA = has_next ? nxt.a : cA; const char* nB = has_next ? nxt.b : cB;
        for (int t = 0; t < nt; t += 2) {
            const bool last = (t == nt - 2);
            const char* a1 = cA + (size_t)(t + 1) * kstep;
            const char* a2 = last ? nA : cA + (size_t)(t + 2) * kstep; const char* b2 = last ? nB : cB + (size_t)(t + 2) * kstep;
            const char* a3 = a2 + kstep; const char* b3 = b2 + kstep;
            PG8_LDB(B0, 0, 0); PG8_LDB(B1, 0, 1); PG8_SCHED; PG8_LDA(At, 0, 0); PG8_STAGE(PG8_SA(1, 1), a1 + hsA, voffA);
            PG8_WAIT_V(8); PG8_WAIT_L(0); PG8_BAR; PG8_MMA(0, 0, At, B0); PG8_MMA(0, 1, At, B1); PG8_BAR; PG8_SCHED;
            PG8_LDA(At, 0, 1); PG8_STAGE(PG8_SB(0, 0), b2, voffB); PG8_STAGE(PG8_SB(0, 1), b2 + hsB, voffB); PG8_STAGE(PG8_SA(0, 0), a2, voffA);
            PG8_WAIT_V(8); PG8_WAIT_L(0); PG8_BAR; PG8_MMA(1, 0, At, B0); PG8_MMA(1, 1, At, B1); PG8_BAR; PG8_SCHED;
            PG8_LDB(B0, 1, 0); PG8_LDB(B1, 1, 1); PG8_SCHED; PG8_LDA(At, 1, 0); PG8_STAGE(PG8_SA(0, 1), a2 + hsA, voffA);
            PG8_WAIT_V(8); PG8_WAIT_L(0); PG8_BAR; PG8_MMA(0, 0, At, B0); PG8_MMA(0, 1, At, B1); PG8_BAR; PG8_SCHED;
            PG8_LDA(At, 1, 1); PG8_STAGE(PG8_SB(1, 0), b3, voffB); PG8_STAGE(PG8_SB(1, 1), b3 + hsB, voffB); PG8_STAGE(PG8_SA(1, 0), a3, voffA);
            PG8_WAIT_V(8); PG8_WAIT_L(0); PG8_BAR; PG8_MMA(1, 0, At, B0); PG8_MMA(1, 1, At, B1); PG8_BAR; PG8_SCHED;
        }
        if (wr == 0) PG8_BAR;
        E(acc, cur, wr, wc, fr, fq);
        if (!has_next) break;
#pragma unroll
        for (int a = 0; a < 2; ++a)
#pragma unroll
            for (int b = 0; b < 2; ++b)
#pragma unroll
                for (int m = 0; m < 4; ++m)
#pragma unroll
                    for (int n = 0; n < 2; ++n) acc[a][b][m][n] = (f32x4){0.f, 0.f, 0.f, 0.f};
        cur = nxt; cA = nA; cB = nB; ++ui;
        if (wr == 1) PG8_BAR;
    }
    PG8_WAIT_V(0);
    PG8_BAR;
#undef PG8_SA
#undef PG8_SB
#undef PG8_STAGE
#undef PG8_LDA
#undef PG8_LDB
#undef PG8_MMA
#undef PG8_WAIT_V
#undef PG8_WAIT_L
#undef PG8_BAR
#undef PG8_SCHED
}

struct EpiStoreBf16 {
    static constexpr bool PERM = true;
    __device__ __forceinline__ void operator()(const f32x4 (&acc)[2][2][4][2], const Unit& u, int wr, int wc, int fr, int fq) const {
        bf16* base = (bf16*)u.o; const size_t ld = (size_t)u.i0;
        const int row0 = wr * 64 + fr, col0 = wc * 32 + 8 * fq;
#pragma unroll
        for (int ai = 0; ai < 2; ++ai)
#pragma unroll
            for (int m = 0; m < 4; ++m) { bf16* rowp = base + (size_t)(row0 + ai * HALF + m * 16) * ld + col0;
#pragma unroll
                for (int bj = 0; bj < 2; ++bj) { const f32x4 v0 = acc[ai][bj][m][0], v1 = acc[ai][bj][m][1];
                    v4u w; w.x = cvt_pk_bf16(v0[0], v0[1]); w.y = cvt_pk_bf16(v0[2], v0[3]); w.z = cvt_pk_bf16(v1[0], v1[1]); w.w = cvt_pk_bf16(v1[2], v1[3]);
                    *(v4u*)(rowp + bj * HALF) = w; } }
    }
};
struct EpiWout {
    static constexpr bool PERM = false;
    const float* x; const float* pos; const float* mod; float* x2;
    __device__ __forceinline__ void operator()(const f32x4 (&acc)[2][2][4][2], const Unit& u, int wr, int wc, int fr, int fq) const {
        const int row0 = u.i0 + wr * 64 + fr, col0 = u.i1 + wc * 32 + 4 * fq; const int b = u.i0 >> 11;
        f32x4 gv[2][2];
#pragma unroll
        for (int bj = 0; bj < 2; ++bj)
#pragma unroll
            for (int n = 0; n < 2; ++n) gv[bj][n] = *(const f32x4*)(mod + b * 6144 + 2 * D + col0 + bj * HALF + n * 16);
#pragma unroll
        for (int ai = 0; ai < 2; ++ai)
#pragma unroll
            for (int m = 0; m < 4; ++m) { const int t = row0 + ai * HALF + m * 16; const size_t ro = (size_t)t * D + col0; const size_t po = (size_t)(t & (SEQ - 1)) * D + col0;
#pragma unroll
                for (int bj = 0; bj < 2; ++bj)
#pragma unroll
                    for (int n = 0; n < 2; ++n) { const int co = bj * HALF + n * 16;
                        const f32x4 xv = *(const f32x4*)(x + ro + co), pv = *(const f32x4*)(pos + po + co);
                        *(f32x4*)(x2 + ro + co) = xv + pv + gv[bj][n] * acc[ai][bj][m][n]; } }
    }
};
struct EpiMoe1 {
    static constexpr bool PERM = true;
    const float* b1; bf16* hh;
    __device__ __forceinline__ void operator()(const f32x4 (&acc)[2][2][4][2], const Unit& u, int wr, int wc, int fr, int fq) const {
        const int row0 = u.i0 + wr * 64 + fr, col0 = u.i1 * HALF + wc * 32 + 8 * fq;
        const float* bb = b1 + (size_t)u.i2 * (2 * DFF) + col0;
        f32x4 bg[2], bl[2];
#pragma unroll
        for (int n = 0; n < 2; ++n) { bg[n] = *(const f32x4*)(bb + 4 * n); bl[n] = *(const f32x4*)(bb + DFF + 4 * n); }
#pragma unroll
        for (int ai = 0; ai < 2; ++ai)
#pragma unroll
            for (int m = 0; m < 4; ++m) { bf16* rowp = hh + (size_t)(row0 + ai * HALF + m * 16) * DFF + col0;
                float r[8];
#pragma unroll
                for (int n = 0; n < 2; ++n) { const f32x4 g = acc[ai][0][m][n] + bg[n], l = acc[ai][1][m][n] + bl[n];
#pragma unroll
                    for (int j = 0; j < 4; ++j) { const float ag = fminf(g[j], 7.0f), al = fminf(fmaxf(l[j], -7.0f), 7.0f);
                        r[4 * n + j] = ag * sigmoidf_(1.702f * ag) * (al + 1.0f); } }
                v4u w; w.x = cvt_pk_bf16(r[0], r[1]); w.y = cvt_pk_bf16(r[2], r[3]); w.z = cvt_pk_bf16(r[4], r[5]); w.w = cvt_pk_bf16(r[6], r[7]);
                *(v4u*)rowp = w; }
    }
};
struct EpiMoe2 {
    static constexpr bool PERM = true;
    const float* b2; bf16* ys;
    __device__ __forceinline__ void operator()(const f32x4 (&acc)[2][2][4][2], const Unit& u, int wr, int wc, int fr, int fq) const {
        const int row0 = u.i0 + wr * 64 + fr, col0 = u.i1 * BM + wc * 32 + 8 * fq;
        const float* bb = b2 + (size_t)u.i2 * D + col0;
        f32x4 bv[2][2];
#pragma unroll
        for (int bj = 0; bj < 2; ++bj)
#pragma unroll
            for (int n = 0; n < 2; ++n) bv[bj][n] = *(const f32x4*)(bb + bj * HALF + 4 * n);
#pragma unroll
        for (int ai = 0; ai < 2; ++ai)
#pragma unroll
            for (int m = 0; m < 4; ++m) { bf16* rowp = ys + (size_t)(row0 + ai * HALF + m * 16) * D + col0;
#pragma unroll
                for (int bj = 0; bj < 2; ++bj) { const f32x4 v0 = acc[ai][bj][m][0] + bv[bj][0], v1 = acc[ai][bj][m][1] + bv[bj][1];
                    v4u w; w.x = cvt_pk_bf16(v0[0], v0[1]); w.y = cvt_pk_bf16(v0[2], v0[3]); w.z = cvt_pk_bf16(v1[0], v1[1]); w.w = cvt_pk_bf16(v1[2], v1[3]);
                    *(v4u*)(rowp + bj * HALF) = w; } }
    }
};
}

struct Frame {
    LAS unsigned char* lds; volatile LAS unsigned* MISC; gu32* ctl;
    int tid, lane, wave, G, bid;
    const float* in[20]; float* out; unsigned char* ws;
};
enum { I_X = 0, I_C, I_CTX, I_CCTX, I_ADAW, I_ADAB, I_N1G, I_WIN, I_LB, I_GN, I_FNW, I_WOUT, I_N2G, I_RW, I_RB, I_W1, I_B1, I_W2, I_B2, I_FG };

__device__ __forceinline__ float wave_sum(float v) {
#pragma unroll
    for (int o = 1; o < 64; o <<= 1) v += __shfl_xor(v, o);
    return v;
}
__device__ __forceinline__ float wave_max(float v) {
#pragma unroll
    for (int o = 1; o < 64; o <<= 1) v = fmaxf(v, __shfl_xor(v, o));
    return v;
}

__device__ __forceinline__ void p0_transpose_item(const float* W, int ldw, int K, int nblk, bf16* WT, LAS float* scr, int item, int lane) {
    const int kb = item / nblk, nb = item % nblk, k0 = 64 * kb, n0 = 32 * nb;
#pragma unroll 8
    for (int i = 0; i < 32; ++i) { const int kk = 2 * i + (lane >> 5); scr[kk * 33 + (lane & 31)] = W[(size_t)(k0 + kk) * ldw + n0 + (lane & 31)]; }
    LDS_WAIT(); asm volatile("" ::: "memory");
    const int c = lane & 7;
#pragma unroll
    for (int j = 0; j < 4; ++j) { const int n = (lane >> 3) + 8 * j; const LAS float* s = scr + (8 * c) * 33 + n;
        v4u o; o.x = pk2(s[0 * 33], s[1 * 33]); o.y = pk2(s[2 * 33], s[3 * 33]); o.z = pk2(s[4 * 33], s[5 * 33]); o.w = pk2(s[6 * 33], s[7 * 33]);
        *(GAS v4u*)(WT + (size_t)(n0 + n) * K + k0 + 8 * c) = o; }
    LDS_WAIT(); asm volatile("" ::: "memory");
}
__device__ __forceinline__ void p0_ada_task(Frame& F, int j) {
    LAS float* s = (LAS float*)F.lds;
    LAS float* red = (LAS float*)(F.lds + 9 * 1024 * 4);
    for (int i = F.tid; i < 9 * 1024; i += NTHR) { const int r = i >> 10, k = i & 1023; const float c = (r < 8) ? F.in[I_C][r * 1024 + k] : F.in[I_CCTX][k]; s[i] = c * sigmoidf_(c); }
    __syncthreads();
    const float* aw = F.in[I_ADAW] + (size_t)(128 * F.wave) * 6144 + 64 * j + F.lane;
    float acc[9];
#pragma unroll
    for (int r = 0; r < 9; ++r) acc[r] = 0.f;
    for (int k0 = 0; k0 < 128; k0 += 8) {
        float a[8];
#pragma unroll
        for (int u = 0; u < 8; ++u) a[u] = aw[(size_t)(k0 + u) * 6144];
#pragma unroll
        for (int u = 0; u < 8; ++u)
#pragma unroll
            for (int r = 0; r < 9; ++r) acc[r] += s[r * 1024 + 128 * F.wave + k0 + u] * a[u];
    }
#pragma unroll
    for (int r = 0; r < 9; ++r) red[(F.wave * 9 + r) * 64 + F.lane] = acc[r];
    __syncthreads();
    float* mod = (float*)(F.ws + WS_MOD);
    for (int i = F.tid; i < 9 * 64; i += NTHR) { const int r = i >> 6, l = i & 63; float v = F.in[I_ADAB][64 * j + l];
#pragma unroll
        for (int w = 0; w < 8; ++w) v += red[(w * 9 + r) * 64 + l];
        mod[r * 6144 + 64 * j + l] = v; }
    __syncthreads();
}
__device__ __forceinline__ void p0_prologue(Frame& F) {
    __syncthreads();
    const int gtid = F.bid * NTHR + F.tid, NGT = F.G * NTHR;
    for (int j = F.bid; j < 96; j += F.G) p0_ada_task(F, j);
    if (F.bid == (96 % F.G)) { float* lb = (float*)(F.ws + WS_LB); for (int i = F.tid; i < 2 * HW; i += NTHR) { const float a = F.in[I_LB][i], b = F.in[I_LB][2 * HW + i]; lb[i] = 1.0f / (1.0f + __expf(b - a)); } }
    { float* pos = (float*)(F.ws + WS_POS);
      for (int i = gtid; i < SEQ * D; i += NGT) { const int l = i >> 10, c = i & 1023, q = c >> 8, j = c & 255;
          const float om = exp2f(-(float)j * (13.287712379549449f / 256.0f)); const float p = (float)((q < 2) ? (l >> 6) : (l & 63)); const float ang = p * om;
          pos[i] = (q & 1) ? cosf(ang) : sinf(ang); } }
    { float* mg = (float*)(F.ws + WS_MG);
      for (int i = gtid; i < NG * GD * 2 * GD; i += NGT) { const int j = i & 255, c = (i >> 8) & 127, g = i >> 15; const int jj = j & 127; const bool isS = j >= 128;
          const float* fw = F.in[I_FNW] + (size_t)g * GD * GD + jj; float acc = 0.f;
          for (int cp = 0; cp < GD; ++cp) { const int m = (c * cp) & 127; float sv, cv; sincospif((float)m * (1.0f / 64.0f), &sv, &cv); acc += (isS ? sv : cv) * fw[cp * GD]; }
          mg[i] = acc * 0.08838834764831845f; } }
    { bf16* dc = (bf16*)(F.ws + WS_DFT); bf16* ds = dc + (size_t)SEQ * SEQ;
      for (int i = gtid; i < SEQ * SEQ / 8; i += NGT) { const int k = i >> 8, l0 = (i & 255) * 8; float cv[8], sv[8];
#pragma unroll
          for (int u = 0; u < 8; ++u) { const int m = (k * (l0 + u)) & 2047; sincospif((float)m * (1.0f / 1024.0f), &sv[u], &cv[u]); cv[u] *= 0.022097086912079608f; sv[u] *= 0.022097086912079608f; }
          v4u a, b; a.x = pk2(cv[0], cv[1]); a.y = pk2(cv[2], cv[3]); a.z = pk2(cv[4], cv[5]); a.w = pk2(cv[6], cv[7]);
          b.x = pk2(sv[0], sv[1]); b.y = pk2(sv[2], sv[3]); b.z = pk2(sv[4], sv[5]); b.w = pk2(sv[6], sv[7]);
          *(v4u*)(dc + (size_t)k * SEQ + l0) = a; *(v4u*)(ds + (size_t)k * SEQ + l0) = b; } }
    LAS float* scr = (LAS float*)(F.lds + F.wave * 16384);
    const int gw = F.bid * NWAVES + F.wave, NGW = F.G * NWAVES;
    constexpr int I_IN = 16 * (NPX / 32), I_OUT = 16 * 32, I_1 = 16 * 64, I_2 = 16 * 32;
    constexpr int NITEMS = I_IN + I_OUT + NE * I_1 + NE * I_2;
    for (int it = gw; it < NITEMS; it += NGW) {
        int r = it;
        if (r < I_IN) { p0_transpose_item(F.in[I_WIN], 3072, D, NPX / 32, (bf16*)(F.ws + WS_WINT), scr, r, F.lane); continue; } r -= I_IN;
        if (r < I_OUT) { p0_transpose_item(F.in[I_WOUT], D, D, 32, (bf16*)(F.ws + WS_WOUT), scr, r, F.lane); continue; } r -= I_OUT;
        if (r < NE * I_1) { const int e = r / I_1; p0_transpose_item(F.in[I_W1] + (size_t)e * D * 2 * DFF, 2 * DFF, D, 64, (bf16*)(F.ws + WS_WB1) + (size_t)e * 2 * DFF * D, scr, r % I_1, F.lane); continue; } r -= NE * I_1;
        { const int e = r / I_2; p0_transpose_item(F.in[I_W2] + (size_t)e * DFF * D, D, DFF, 32, (bf16*)(F.ws + WS_WB2) + (size_t)e * D * DFF, scr, r % I_2, F.lane); }
    }
}

__device__ __forceinline__ void p1_row(Frame& F, int t) {
    const float* mod = (const float*)(F.ws + WS_MOD); const float* g1 = F.in[I_N1G];
    const bool lat = t < T; const int b = lat ? (t >> 11) : 8;
    const GAS f32x4* xr = (const GAS f32x4*)(lat ? F.in[I_X] + (size_t)t * D : F.in[I_CTX] + (size_t)(t - T) * D) + F.lane;
    const GAS f32x4* pr = (const GAS f32x4*)((const float*)(F.ws + WS_POS) + (size_t)(t & (SEQ - 1)) * D) + F.lane;
    f32x4 v[4]; float ss = 0.f;
#pragma unroll
    for (int j = 0; j < 4; ++j) { v[j] = xr[64 * j]; if (lat) v[j] = v[j] + pr[64 * j]; ss += (v[j].x * v[j].x + v[j].y * v[j].y) + (v[j].z * v[j].z + v[j].w * v[j].w); }
    const float rinv = 1.0f / sqrtf(wave_sum(ss) * (1.0f / D) + NORM_EPS);
    GAS unsigned long long* o8 = (GAS unsigned long long*)((bf16*)(F.ws + WS_HMOD) + (size_t)t * D) + F.lane;
#pragma unroll
    for (int j = 0; j < 4; ++j) { const int c = 4 * F.lane + 256 * j;
        const f32x4 g = *(const f32x4*)(g1 + c), sh = *(const f32x4*)(mod + b * 6144 + c), sc = *(const f32x4*)(mod + b * 6144 + D + c);
        const f32x4 h = v[j] * rinv * g * (sc + 1.0f) + sh;
        o8[64 * j] = (unsigned long long)pk2(h.x, h.y) | ((unsigned long long)pk2(h.z, h.w) << 32); }
}
__device__ __forceinline__ void p1_fold_task(Frame& F, int task) {
    const int kb = task & 15, pq = (task >> 4) & 1, g = task >> 5, k0 = 64 * kb;
    LAS float* wt = (LAS float*)F.lds;
    LAS float* mh = (LAS float*)(F.lds + 64 * 129 * 4);
    const float* mg = (const float*)(F.ws + WS_MG) + (size_t)g * GD * 256 + pq * 128;
    for (int i = F.tid; i < 64 * 128; i += NTHR) { const int kk = i >> 7, c = i & 127; wt[kk * 129 + c] = F.in[I_WIN][(size_t)(k0 + kk) * 3072 + NPX + g * GD + c]; }
    for (int i = F.tid; i < 128 * 128; i += NTHR) { const int c = i >> 7, j = i & 127; mh[i] = mg[c * 256 + j]; }
    __syncthreads();
    const int kk = F.tid & 63, jg = F.tid >> 6;
    float acc[16];
#pragma unroll
    for (int i = 0; i < 16; ++i) acc[i] = 0.f;
    for (int c = 0; c < 128; ++c) { const float w = wt[kk * 129 + c]; const LAS f32x4* m4 = (const LAS f32x4*)(mh + c * 128 + jg * 16);
#pragma unroll
        for (int q = 0; q < 4; ++q) { const f32x4 mv = m4[q]; acc[4 * q] += w * mv.x; acc[4 * q + 1] += w * mv.y; acc[4 * q + 2] += w * mv.z; acc[4 * q + 3] += w * mv.w; } }
    bf16* wf = (bf16*)(F.ws + WS_WINT) + (size_t)NPX * D;
#pragma unroll
    for (int i = 0; i < 16; ++i) wf[(size_t)(pq * 512 + g * GD + jg * 16 + i) * D + k0 + kk] = (bf16)f2bf(acc[i]);
    __syncthreads();
}
__device__ __forceinline__ void p1_phase(Frame& F) {
    for (int task = F.bid; task < 128; task += F.G) p1_fold_task(F, task);
    const int gw = F.bid * NWAVES + F.wave, NGW = F.G * NWAVES;
    for (int t = gw; t < TA; t += NGW) p1_row(F, t);
}

struct SchedInproj {
    int G, c; const char* hmod; const char* wint; char* px; char* pt;
    __device__ __forceinline__ bool next(int i, pg8::Unit& u) const {
        const int L = i * G + c;
        if (L < 720) { int pm, pn; pg8::tile_of(L, 72, 10, pm, pn);
            u.a = hmod + (size_t)pm * 256 * D * 2; u.b = wint + (size_t)pn * 256 * D * 2; u.o = px + ((size_t)pm * 256 * NPX + (size_t)pn * 256) * 2; u.i0 = NPX; u.i1 = u.i2 = u.i3 = 0; return true; }
        if (L < 976) { int pm, pn; pg8::tile_of(L - 720, 4, 64, pm, pn);
            const int pq = pm >> 1, c0 = (pm & 1) * 256, b = pn >> 3, l0 = (pn & 7) * 256;
            u.a = wint + (size_t)(NPX + pm * 256) * D * 2; u.b = hmod + (size_t)pn * 256 * D * 2;
            u.o = pt + ((((size_t)(pq * 8 + b) * 512 + c0) * SEQ) + l0) * 2; u.i0 = SEQ; u.i1 = u.i2 = u.i3 = 0; return true; }
        return false;
    }
};
namespace gla {
constexpr int GP = 272, GP64 = 144;
constexpr int L_QI = 0, L_KI = L_QI + 64 * GP, L_KIT = L_KI + 64 * GP, L_VT = L_KIT + 128 * GP64, L_TT = L_VT + 32 * GP64, L_P = L_TT + 32 * GP, L_TOT = L_P + 64 * GP64, L_C = L_TOT + 4096, L_END = L_C + 1024;
static_assert(L_END <= RING_BYTES, "gla lds");
}
#define GLA_MFMA(a, b, c) __builtin_amdgcn_mfma_f32_16x16x32_bf16((a), (b), (c), 0, 0, 0)
__device__ __forceinline__ void p3_gla_chunked(Frame& F, int chain) {
    using namespace gla;
    const int vq = chain & 3, dir = (chain >> 2) & 1, h = (chain >> 3) & 3, b = chain >> 5;
    LAS unsigned char* L = F.lds;
    const bf16* px = (const bf16*)(F.ws + WS_PX);
    const float* lbp = (const float*)(F.ws + WS_LB) + dir * HW + h * HD;
    float* og = (float*)(F.ws + WS_OGLA) + (size_t)dir * T * HW;
    const int lane = F.lane, w = F.wave, g = lane >> 4, li = lane & 15;
    const int zcol = 3 * HW + dir * HW + h * HD + 2 * lane, qcol = h * HD + 2 * lane, vcol = HW + h * HD + vq * 32 + (F.tid & 7) * 4;
    const float lb0 = lbp[2 * lane], lb1 = lbp[2 * lane + 1];
    f32x4 S0 = (f32x4){0.f, 0.f, 0.f, 0.f}, S1 = (f32x4){0.f, 0.f, 0.f, 0.f};
    constexpr int NBLK = (CTX + SEQ) / 64;
    unsigned zr[8], qr[8]; v2u vr;
#define GLA_ROWBASE(blk) (((blk) < CTX / 64) ? (size_t)(T + b * CTX + ((dir == 0) ? (blk) * 64 : (CTX - 64 - (blk) * 64))) : (size_t)(b * SEQ + ((dir == 0) ? ((blk) - CTX / 64) * 64 : (SEQ - 64 - ((blk) - CTX / 64) * 64))))
#define GLA_LOAD(blk) do { const size_t rb_ = GLA_ROWBASE(blk); const bool lat_ = (blk) >= CTX / 64; \
        _Pragma("unroll") for (int i = 0; i < 8; ++i) { const int tl = 8 * w + i; const bf16* pr = px + (rb_ + (dir ? 63 - tl : tl)) * NPX; zr[i] = *(const unsigned*)(pr + zcol); qr[i] = lat_ ? *(const unsigned*)(pr + qcol) : 0u; } \
        { const int tl = F.tid >> 3; vr = *(const v2u*)(px + (rb_ + (dir ? 63 - tl : tl)) * NPX + vcol); } } while (0)
    GLA_LOAD(0);
    for (int blk = 0; blk < NBLK; ++blk) {
        const bool lat = blk >= CTX / 64;
        const size_t rowbase = GLA_ROWBASE(blk);
        float c0[8], c1[8], k0[8], k1[8], q0[8], q1[8];
        { float a0 = 0.f, a1 = 0.f;
#pragma unroll
          for (int i = 0; i < 8; ++i) { const float f0 = lb0 + (1.0f - lb0) * sigmoidf_(bflo(zr[i])), f1 = lb1 + (1.0f - lb1) * sigmoidf_(bfhi(zr[i]));
              a0 += __logf(f0); a1 += __logf(f1); c0[i] = a0; c1[i] = a1; k0[i] = 1.0f - f0; k1[i] = 1.0f - f1; q0[i] = bflo(qr[i]); q1[i] = bfhi(qr[i]); }
          *(LAS f32x2*)(L + L_TOT + (w * 128 + 2 * lane) * 4) = (f32x2){a0, a1}; }
        const v2u vcur = vr;
        if (blk + 1 < NBLK) GLA_LOAD(blk + 1);
        __syncthreads();
        { float pre0 = 0.f, pre1 = 0.f, br0 = 0.f, br1 = 0.f, bl0 = 0.f, bl1 = 0.f;
#pragma unroll
          for (int t2 = 0; t2 < 8; ++t2) { const f32x2 tt = *(const LAS f32x2*)(L + L_TOT + (t2 * 128 + 2 * lane) * 4);
              if (t2 < w) { pre0 += tt.x; pre1 += tt.y; } if (t2 < 4) { br0 += tt.x; br1 += tt.y; } bl0 += tt.x; bl1 += tt.y; }
          unsigned kp0[4], kp1[4];
#pragma unroll
          for (int i = 0; i < 8; i += 2) {
              const float ea0 = __expf(pre0 + c0[i] - br0), ea1 = __expf(pre1 + c1[i] - br1), eb0 = __expf(pre0 + c0[i + 1] - br0), eb1 = __expf(pre1 + c1[i + 1] - br1);
              const float ka0 = k0[i] * __builtin_amdgcn_rcpf(ea0), ka1 = k1[i] * __builtin_amdgcn_rcpf(ea1), kb0 = k0[i + 1] * __builtin_amdgcn_rcpf(eb0), kb1 = k1[i + 1] * __builtin_amdgcn_rcpf(eb1);
              const int t = 8 * w + i;
              if (lat) { *(LAS unsigned*)(L + L_QI + t * GP + 4 * lane) = pg8::cvt_pk_bf16(q0[i] * ea0, q1[i] * ea1); *(LAS unsigned*)(L + L_QI + (t + 1) * GP + 4 * lane) = pg8::cvt_pk_bf16(q0[i + 1] * eb0, q1[i + 1] * eb1);
                         *(LAS unsigned*)(L + L_KI + t * GP + 4 * lane) = pg8::cvt_pk_bf16(ka0, ka1); *(LAS unsigned*)(L + L_KI + (t + 1) * GP + 4 * lane) = pg8::cvt_pk_bf16(kb0, kb1); }
              kp0[i >> 1] = pg8::cvt_pk_bf16(ka0, kb0); kp1[i >> 1] = pg8::cvt_pk_bf16(ka1, kb1); }
          *(LAS v4u*)(L + L_KIT + (2 * lane) * GP64 + w * 16) = (v4u){kp0[0], kp0[1], kp0[2], kp0[3]};
          *(LAS v4u*)(L + L_KIT + (2 * lane + 1) * GP64 + w * 16) = (v4u){kp1[0], kp1[1], kp1[2], kp1[3]};
          if (w == 0) { *(LAS f32x2*)(L + L_C + 2 * lane * 4) = (f32x2){__expf(br0), __expf(br1)}; *(LAS f32x2*)(L + L_C + (128 + 2 * lane) * 4) = (f32x2){__expf(bl0 - br0), __expf(bl1 - br1)}; } }
        { const int tl = F.tid >> 3, c4 = (F.tid & 7) * 4;
          *(LAS unsigned short*)(L + L_VT + (c4 + 0) * GP64 + tl * 2) = (unsigned short)(vcur.x & 0xffffu); *(LAS unsigned short*)(L + L_VT + (c4 + 1) * GP64 + tl * 2) = (unsigned short)(vcur.x >> 16);
          *(LAS unsigned short*)(L + L_VT + (c4 + 2) * GP64 + tl * 2) = (unsigned short)(vcur.y & 0xffffu); *(LAS unsigned short*)(L + L_VT + (c4 + 3) * GP64 + tl * 2) = (unsigned short)(vcur.y >> 16); }
        __syncthreads();
        const f32x4 c1v = *(const LAS f32x4*)(L + L_C + (16 * w + 4 * g) * 4), c2v = *(const LAS f32x4*)(L + L_C + (128 + 16 * w + 4 * g) * 4);
        const f32x4 T0 = S0 * c1v, T1 = S1 * c1v;
        if (lat) {
            *(LAS v2u*)(L + L_TT + li * GP + (16 * w + 4 * g) * 2) = (v2u){pg8::cvt_pk_bf16(T0.x, T0.y), pg8::cvt_pk_bf16(T0.z, T0.w)};
            *(LAS v2u*)(L + L_TT + (16 + li) * GP + (16 * w + 4 * g) * 2) = (v2u){pg8::cvt_pk_bf16(T1.x, T1.y), pg8::cvt_pk_bf16(T1.z, T1.w)};
            const int ti = w & 3;
#pragma unroll
            for (int jj = 0; jj < 2; ++jj) { const int tj = 2 * (w >> 2) + jj; f32x4 acc = (f32x4){0.f, 0.f, 0.f, 0.f};
                if (tj <= ti) {
#pragma unroll
                    for (int ks = 0; ks < 4; ++ks) { const bf16x8 a = *(const LAS bf16x8*)(L + L_QI + (16 * ti + li) * GP + ks * 64 + g * 16), bb = *(const LAS bf16x8*)(L + L_KI + (16 * tj + li) * GP + ks * 64 + g * 16); acc = GLA_MFMA(a, bb, acc); } }
#pragma unroll
                for (int r = 0; r < 4; ++r) { const bool keep = (tj < ti) || (tj == ti && li <= 4 * g + r); const float val = keep ? acc[r] : 0.0f;
                    *(LAS unsigned short*)(L + L_P + (16 * ti + 4 * g + r) * GP64 + (16 * tj + li) * 2) = (unsigned short)f2bf(val); } }
        }
        __syncthreads();
        if (lat) { const int ti = w & 3, vj = w >> 2; f32x4 acc = (f32x4){0.f, 0.f, 0.f, 0.f};
#pragma unroll
            for (int ks = 0; ks < 2; ++ks) { const bf16x8 a = *(const LAS bf16x8*)(L + L_P + (16 * ti + li) * GP64 + ks * 64 + g * 16), bb = *(const LAS bf16x8*)(L + L_VT + (16 * vj + li) * GP64 + ks * 64 + g * 16); acc = GLA_MFMA(a, bb, acc); }
#pragma unroll
            for (int ks = 0; ks < 4; ++ks) { const bf16x8 a = *(const LAS bf16x8*)(L + L_QI + (16 * ti + li) * GP + ks * 64 + g * 16), bb = *(const LAS bf16x8*)(L + L_TT + (16 * vj + li) * GP + ks * 64 + g * 16); acc = GLA_MFMA(a, bb, acc); }
#pragma unroll
            for (int r = 0; r < 4; ++r) { const int tl = 16 * ti + 4 * g + r; og[(rowbase + (dir ? 63 - tl : tl)) * HW + h * HD + vq * 32 + 16 * vj + li] = acc[r]; } }
        { f32x4 a0 = T0, a1 = T1;
#pragma unroll
          for (int ks = 0; ks < 2; ++ks) { const bf16x8 a = *(const LAS bf16x8*)(L + L_KIT + (16 * w + li) * GP64 + ks * 64 + g * 16);
              const bf16x8 b0 = *(const LAS bf16x8*)(L + L_VT + li * GP64 + ks * 64 + g * 16), b1 = *(const LAS bf16x8*)(L + L_VT + (16 + li) * GP64 + ks * 64 + g * 16);
              a0 = GLA_MFMA(a, b0, a0); a1 = GLA_MFMA(a, b1, a1); }
          S0 = a0 * c2v; S1 = a1 * c2v; }
        __syncthreads();
    }
#undef GLA_LOAD
#undef GLA_ROWBASE
}
struct SchedFourier {
    int G, c; const char* dft; const char* pt; char* eo;
    __device__ __forceinline__ bool next(int i, pg8::Unit& u) const {
        const int L = i * G + c; if (L >= 256) return false;
        const int b = L & 7, r = L >> 3, kt = r >> 2, pn = r & 3, pq = pn >> 1;
        u.a = dft + ((size_t)pq * SEQ * SEQ + (size_t)kt * 256 * SEQ) * 2;
        u.b = pt + (((size_t)(pq * 8 + b) * 512 + (pn & 1) * 256) * SEQ) * 2;
        u.o = eo + (((size_t)b * SEQ + kt * 256) * D + pn * 256) * 2; u.i0 = D; u.i1 = u.i2 = u.i3 = 0; return true;
    }
};
__device__ __forceinline__ void p3c_row(Frame& F, int t) {
    const float* o0 = (const float*)(F.ws + WS_OGLA) + (size_t)t * HW + 8 * F.lane; const float* o1 = o0 + (size_t)T * HW;
    const f32x4 a0 = *(const f32x4*)o0, a1 = *(const f32x4*)(o0 + 4), b0 = *(const f32x4*)o1, b1 = *(const f32x4*)(o1 + 4);
    float o[8] = {a0.x + b0.x, a0.y + b0.y, a0.z + b0.z, a0.w + b0.w, a1.x + b1.x, a1.y + b1.y, a1.z + b1.z, a1.w + b1.w};
    float ss = 0.f;
#pragma unroll
    for (int i = 0; i < 8; ++i) ss += o[i] * o[i];
    ss += __shfl_xor(ss, 1); ss += __shfl_xor(ss, 2); ss += __shfl_xor(ss, 4); ss += __shfl_xor(ss, 8);
    const float rinv = 1.0f / sqrtf(ss * (1.0f / HD) + NORM_EPS);
    const float* gn = F.in[I_GN] + ((8 * F.lane) & 127);
    const v4u gz = *(const v4u*)((const bf16*)(F.ws + WS_PX) + (size_t)t * NPX + 2 * HW + 8 * F.lane);
    const unsigned gg[4] = {gz.x, gz.y, gz.z, gz.w};
    float hx[8];
#pragma unroll
    for (int u = 0; u < 4; ++u) { hx[2 * u] = o[2 * u] * rinv * gn[2 * u] * sigmoidf_(bflo(gg[u])); hx[2 * u + 1] = o[2 * u + 1] * rinv * gn[2 * u + 1] * sigmoidf_(bfhi(gg[u])); }
    bf16* mix = (bf16*)(F.ws + WS_MIX) + (size_t)t * D;
    v4u w; w.x = pk2(hx[0], hx[1]); w.y = pk2(hx[2], hx[3]); w.z = pk2(hx[4], hx[5]); w.w = pk2(hx[6], hx[7]);
    *(v4u*)(mix + 8 * F.lane) = w;
    const bf16* eo = (const bf16*)(F.ws + WS_EO) + (size_t)t * D + 8 * F.lane;
    const v4u e = *(const v4u*)eo, q = *(const v4u*)(eo + 512);
    v4u f; f.x = pk2(bflo(e.x) - bflo(q.x), bfhi(e.x) - bfhi(q.x)); f.y = pk2(bflo(e.y) - bflo(q.y), bfhi(e.y) - bfhi(q.y));
    f.z = pk2(bflo(e.z) - bflo(q.z), bfhi(e.z) - bfhi(q.z)); f.w = pk2(bflo(e.w) - bflo(q.w), bfhi(e.w) - bfhi(q.w));
    *(v4u*)(mix + HW + 8 * F.lane) = f;
}
struct SchedWout {
    int G, c; const char* mix; const char* wout;
    __device__ __forceinline__ bool next(int i, pg8::Unit& u) const {
        const int L = i * G + c; if (L >= 256) return false;
        int pm, pn; pg8::tile_of(L, 64, 4, pm, pn);
        u.a = mix + (size_t)pm * 256 * D * 2; u.b = wout + (size_t)pn * 256 * D * 2; u.o = nullptr; u.i0 = pm * 256; u.i1 = pn * 256; u.i2 = u.i3 = 0; return true;
    }
};
__device__ __forceinline__ void p5a_phase(Frame& F, int cw_cnt) {
    LAS float* wrT = (LAS float*)F.lds;
    volatile LAS unsigned* lcnt = F.MISC + 16;
    volatile LAS unsigned* lbase = F.MISC + 48;
    const float* rw = F.in[I_RW];
    for (int i = F.tid; i < D * NE; i += NTHR) { const int k = i >> 5, e = i & 31; wrT[e * 1024 + k] = rw[i]; }
    const float* mod = (const float*)(F.ws + WS_MOD); const float* g2 = F.in[I_N2G];
    int* tok_e = (int*)(F.ws + WS_ROUTE); int* tok_pos = tok_e + T * 4; float* tok_w = (float*)(tok_pos + T * 4);
    for (int base = F.bid * 64; base < T; base += F.G * 64) {
        if (F.tid < 32) lcnt[F.tid] = 0u;
        __syncthreads();
        int my_e = 0; unsigned my_rank = 0; float my_w = 0.f;
#pragma unroll 1
        for (int i = 0; i < 8; ++i) {
            const int t = base + F.wave * 8 + i; const int b = t >> 11;
            const GAS f32x4* xr = (const GAS f32x4*)((const float*)(F.ws + WS_X2) + (size_t)t * D) + F.lane;
            f32x4 v[4]; float ss = 0.f;
#pragma unroll
            for (int j = 0; j < 4; ++j) { v[j] = xr[64 * j]; ss += (v[j].x * v[j].x + v[j].y * v[j].y) + (v[j].z * v[j].z + v[j].w * v[j].w); }
            const float rinv = 1.0f / sqrtf(wave_sum(ss) * (1.0f / D) + NORM_EPS);
            GAS unsigned long long* o8 = (GAS unsigned long long*)((bf16*)(F.ws + WS_HM) + (size_t)t * D) + F.lane;
#pragma unroll
            for (int j = 0; j < 4; ++j) { const int c = 4 * F.lane + 256 * j;
                const f32x4 g = *(const f32x4*)(g2 + c), sh = *(const f32x4*)(mod + b * 6144 + 3 * D + c), sc = *(const f32x4*)(mod + b * 6144 + 4 * D + c);
                v[j] = v[j] * rinv * g * (sc + 1.0f) + sh;
                o8[64 * j] = (unsigned long long)pk2(v[j].x, v[j].y) | ((unsigned long long)pk2(v[j].z, v[j].w) << 32); }
            float acc[32];
#pragma unroll
            for (int e = 0; e < 32; ++e) { float a = 0.f;
                if ((e & 3) == 0) asm volatile("" ::: "memory");
#pragma unroll
                for (int j = 0; j < 4; ++j) { const f32x4 w = *(const LAS f32x4*)(wrT + e * 1024 + 4 * F.lane + 256 * j); a += v[j].x * w.x + v[j].y * w.y + v[j].z * w.z + v[j].w * w.w; }
                acc[e] = a; }
#define P5_HALVE(N, MASK) _Pragma("unroll") for (int j = 0; j < N; ++j) { const bool hi = (F.lane & MASK) != 0; const float keep = hi ? acc[j + N] : acc[j]; const float send = hi ? acc[j] : acc[j + N]; acc[j] = keep + __shfl_xor(send, MASK); }
            P5_HALVE(16, 32) P5_HALVE(8, 16) P5_HALVE(4, 8) P5_HALVE(2, 4) P5_HALVE(1, 2)
#undef P5_HALVE
            float lg = acc[0] + __shfl_xor(acc[0], 1);
            const int e_me = F.lane >> 1;
            lg += F.in[I_RB][e_me];
            float tv0, tv1, tv2, tv3; int te0, te1, te2, te3;
#define P5_TOP(TV, TE) { const float m = wave_max(lg); const unsigned long long bal = __ballot(lg == m); const int ln = __ffsll((long long)bal) - 1; TE = ln >> 1; TV = m; if (e_me == TE) lg = -3.0e38f; }
            P5_TOP(tv0, te0) P5_TOP(tv1, te1) P5_TOP(tv2, te2) P5_TOP(tv3, te3)
#undef P5_TOP
            const float e1 = __expf(tv1 - tv0), e2 = __expf(tv2 - tv0), e3 = __expf(tv3 - tv0); const float inv = 1.0f / (1.0f + e1 + e2 + e3);
            if ((F.lane >> 2) == i && F.lane < 32) { const int k = F.lane & 3; my_e = te0; my_w = inv;
                if (k == 1) { my_e = te1; my_w = e1 * inv; } if (k == 2) { my_e = te2; my_w = e2 * inv; } if (k == 3) { my_e = te3; my_w = e3 * inv; } }
        }
        if (F.lane < 32) my_rank = __hip_atomic_fetch_add((LAS unsigned*)lcnt + my_e, 1u, __ATOMIC_RELAXED, __HIP_MEMORY_SCOPE_WORKGROUP);
        __syncthreads();
        if (F.tid < 32) lbase[F.tid] = __hip_atomic_fetch_add((unsigned*)(F.ctl + cw_cnt) + F.tid, lcnt[F.tid], __ATOMIC_RELAXED, __HIP_MEMORY_SCOPE_AGENT);
        __syncthreads();
        if (F.lane < 32) { const int t = base + F.wave * 8 + (F.lane >> 2); const int idx = t * 4 + (F.lane & 3);
            tok_e[idx] = my_e; tok_pos[idx] = (int)(lbase[my_e] + my_rank); tok_w[idx] = my_w; }
        __syncthreads();
    }
}
__device__ __forceinline__ void moe_offsets(Frame& F, volatile LAS unsigned* boff) {
    if (F.tid == 0) { unsigned acc = 0; for (int e = 0; e < NE; ++e) { boff[e] = acc; acc += (((const unsigned*)(F.ctl + CW_CNT))[e] + 255u) >> 8; } boff[NE] = acc; }
    __syncthreads();
}
__device__ __forceinline__ void p5c_phase(Frame& F) {
    volatile LAS unsigned* boff = F.MISC + 16;
    moe_offsets(F, boff);
    const int* tok_e = (const int*)(F.ws + WS_ROUTE); const int* tok_pos = tok_e + T * 4; int* tok_slot = (int*)(F.ws + WS_ROUTE) + 3 * T * 4;
    const int gw = F.bid * NWAVES + F.wave, NGW = F.G * NWAVES;
    for (int t = gw; t < T; t += NGW) {
        const GAS v4u* src = (const GAS v4u*)((const bf16*)(F.ws + WS_HM) + (size_t)t * D) + F.lane;
        const v4u r0 = src[0], r1 = src[64];
#pragma unroll
        for (int k = 0; k < 4; ++k) { const int e = tok_e[t * 4 + k]; const int slot = (int)(boff[e] * 256u) + tok_pos[t * 4 + k];
            GAS v4u* dst = (GAS v4u*)((bf16*)(F.ws + WS_HMP) + (size_t)slot * D) + F.lane; dst[0] = r0; dst[64] = r1;
            if (F.lane == 0) tok_slot[t * 4 + k] = slot; }
    }
}
template <int NPN, int MODE>
struct SchedMoe {
    int r, nmem, x; unsigned n0, n1, n2, n3, b0, b1, b2, b3; const char* A; const char* B;
    __device__ __forceinline__ void init(Frame& F, volatile LAS unsigned* boff, const char* A_, const char* B_) {
        x = F.bid & 7; r = F.bid >> 3; nmem = (F.G + 7 - x) / 8; A = A_; B = B_;
        b0 = boff[x]; n0 = boff[x + 1] - b0; b1 = boff[x + 8]; n1 = boff[x + 9] - b1; b2 = boff[x + 16]; n2 = boff[x + 17] - b2; b3 = boff[x + 24]; n3 = boff[x + 25] - b3;
        if ((F.G & 7) != 0) { nmem = 0; }
    }
    __device__ __forceinline__ bool next(int i, pg8::Unit& u) const {
        if (nmem == 0) return false;
        const unsigned j = (unsigned)(i * nmem + r); unsigned blk = j / NPN; const int pn = (int)(j % NPN);
        int e; unsigned gb;
        if (blk < n0) { e = x; gb = b0 + blk; }
        else { blk -= n0;
            if (blk < n1) { e = x + 8; gb = b1 + blk; }
            else { blk -= n1;
                if (blk < n2) { e = x + 16; gb = b2 + blk; }
                else { blk -= n2; if (blk >= n3) return false; e = x + 24; gb = b3 + blk; } } }
        u.a = A + (size_t)gb * 256 * D * 2;
        if (MODE == 1) u.b = B + ((size_t)e * 2 * DFF + (size_t)pn * 128) * D * 2; else u.b = B + ((size_t)e * D + (size_t)pn * 256) * DFF * 2;
        u.o = nullptr; u.i0 = (int)gb * 256; u.i1 = pn; u.i2 = e; u.i3 = 0; return true;
    }
};
__device__ __forceinline__ void p8_row(Frame& F, int t) {
    const int b = t >> 11; const float* mod = (const float*)(F.ws + WS_MOD);
    const int* tok_slot = (const int*)(F.ws + WS_ROUTE) + 3 * T * 4; const float* tok_w = (const float*)(F.ws + WS_ROUTE) + 2 * T * 4;
    const GAS f32x4* xr = (const GAS f32x4*)((const float*)(F.ws + WS_X2) + (size_t)t * D) + F.lane;
    f32x4 v[4], m[4];
#pragma unroll
    for (int j = 0; j < 4; ++j) { v[j] = xr[64 * j]; m[j] = (f32x4){0.f, 0.f, 0.f, 0.f}; }
#pragma unroll
    for (int k = 0; k < 4; ++k) { const int slot = tok_slot[t * 4 + k]; const float w = tok_w[t * 4 + k];
        const GAS v2u* yr = (const GAS v2u*)((const bf16*)(F.ws + WS_YS) + (size_t)slot * D) + F.lane;
#pragma unroll
        for (int j = 0; j < 4; ++j) { const v2u y = yr[64 * j]; m[j].x += w * bflo(y.x); m[j].y += w * bfhi(y.x); m[j].z += w * bflo(y.y); m[j].w += w * bfhi(y.y); } }
    float ss = 0.f;
#pragma unroll
    for (int j = 0; j < 4; ++j) { const f32x4 g = *(const f32x4*)(mod + b * 6144 + 5 * D + 4 * F.lane + 256 * j); v[j] = v[j] + g * m[j];
        ss += (v[j].x * v[j].x + v[j].y * v[j].y) + (v[j].z * v[j].z + v[j].w * v[j].w); }
    const float rinv = 1.0f / sqrtf(wave_sum(ss) * (1.0f / D) + NORM_EPS);
    GAS f32x4* orow = (GAS f32x4*)(F.out + (size_t)t * D) + F.lane;
#pragma unroll
    for (int j = 0; j < 4; ++j) { const f32x4 g = *(const f32x4*)(F.in[I_FG] + 4 * F.lane + 256 * j); orow[64 * j] = v[j] * rinv * g; }
}

constexpr int N_PHASES = 11;
struct Args { const float* in[20]; float* out; unsigned char* ws; int ph_lo, ph_hi; };
__global__ void __launch_bounds__(NTHR, 2) fwd_kernel(Args args) {
    extern __shared__ __attribute__((aligned(16))) unsigned char lds[];
    Frame F;
    F.lds = (LAS unsigned char*)lds; F.MISC = (volatile LAS unsigned*)(F.lds + MISC_OFF);
    F.tid = threadIdx.x; F.lane = F.tid & 63; F.wave = __builtin_amdgcn_readfirstlane(F.tid >> 6);
    F.G = gridDim.x; F.bid = blockIdx.x;
#pragma unroll
    for (int i = 0; i < 20; ++i) F.in[i] = args.in[i];
    F.out = args.out; F.ws = args.ws; F.ctl = (gu32*)(args.ws + WS_CTL);
    for (int u = F.tid; u < (LDS_BYTES - LDSCTL_OFF) / 4; u += NTHR) ((LAS unsigned*)(F.lds + LDSCTL_OFF))[u] = 0u;
    __syncthreads();
    const int lo = args.ph_lo, hi = args.ph_hi;
    const bool multi = (hi - lo) > 1;
    XcdBarrier bar; bar.bar = (unsigned*)(F.ctl + CW_BAR); bar.x = 0; bar.st = nullptr;
    if (multi) bar = xcd_barrier_post((unsigned*)(F.ctl + CW_BAR), F.MISC + 8);
#define IN(k) (lo <= (k) && (k) < hi)
#define REPS(k) _Pragma("unroll") for (int _rep = 0; _rep < (((k) == PROBE_PHASE) ? PROBE_REPS : 1); ++_rep)
#define SEAM(k) do { if (IN(k) && IN((k) + 1)) xcd_barrier(bar); } while (0)
    const int gw = F.bid * NWAVES + F.wave, NGW = F.G * NWAVES;

    if (IN(0)) REPS(0) { p0_prologue(F); }
    SEAM(0);
    if (IN(1)) REPS(1) { p1_phase(F); }
    SEAM(1);
    if (IN(2)) REPS(2) {
        SchedInproj S{F.G, F.bid, (const char*)(F.ws + WS_HMOD), (const char*)(F.ws + WS_WINT), (char*)(F.ws + WS_PX), (char*)(F.ws + WS_PT)};
        pg8::EpiStoreBf16 E;
        pg8::gemm_phase(F.lds, D, (size_t)128 * D * 2, (size_t)128 * D * 2, S, E);
    }
    SEAM(2);
    if (IN(3)) {
        REPS(30) { for (int ch = F.bid; ch < 256; ch += F.G) p3_gla_chunked(F, ch); }
        REPS(31) {
        SchedFourier S{F.G, F.bid, (const char*)(F.ws + WS_DFT), (const char*)(F.ws + WS_PT), (char*)(F.ws + WS_EO)};
        pg8::EpiStoreBf16 E;
        pg8::gemm_phase(F.lds, SEQ, (size_t)128 * SEQ * 2, (size_t)128 * SEQ * 2, S, E);
        }
    }
    SEAM(3);
    if (IN(4)) REPS(4) { for (int t = gw; t < T; t += NGW) p3c_row(F, t); }
    SEAM(4);
    if (IN(5)) REPS(5) {
        SchedWout S{F.G, F.bid, (const char*)(F.ws + WS_MIX), (const char*)(F.ws + WS_WOUT)};
        pg8::EpiWout E{F.in[I_X], (const float*)(F.ws + WS_POS), (const float*)(F.ws + WS_MOD), (float*)(F.ws + WS_X2)};
        pg8::gemm_phase(F.lds, D, (size_t)128 * D * 2, (size_t)128 * D * 2, S, E);
    }
    SEAM(5);
    if (IN(6)) REPS(6) { __syncthreads(); p5a_phase(F, CW_CNT0 + 32 * _rep); }
    SEAM(6);
    if (IN(7)) REPS(7) { p5c_phase(F); }
    SEAM(7);
    if (IN(8)) REPS(8) {
        volatile LAS unsigned* boff = F.MISC + 16; moe_offsets(F, boff);
        SchedMoe<8, 1> S; S.init(F, boff, (const char*)(F.ws + WS_HMP), (const char*)(F.ws + WS_WB1));
        pg8::EpiMoe1 E{F.in[I_B1], (bf16*)(F.ws + WS_HH)};
        pg8::gemm_phase(F.lds, D, (size_t)128 * D * 2, (size_t)DFF * D * 2, S, E);
    }
    SEAM(8);
    if (IN(9)) REPS(9) {
        volatile LAS unsigned* boff = F.MISC + 16; moe_offsets(F, boff);
        SchedMoe<4, 2> S; S.init(F, boff, (const char*)(F.ws + WS_HH), (const char*)(F.ws + WS_WB2));
        pg8::EpiMoe2 E{F.in[I_B2], (bf16*)(F.ws + WS_YS)};
        pg8::gemm_phase(F.lds, DFF, (size_t)128 * DFF * 2, (size_t)128 * DFF * 2, S, E);
    }
    SEAM(9);
    if (IN(10)) REPS(10) { for (int t = gw; t < T; t += NGW) p8_row(F, t); }
#undef IN
#undef SEAM
}

extern "C" void kernel_launch(void* const* d_in, const int* in_sizes, int n_in, void* d_out, int out_size, void* d_ws, size_t ws_size, hipStream_t stream) {
    static int grid = 0;
    if (grid == 0) {
        if (n_in != 20 || out_size != T * D || ws_size < WS_END) { fprintf(stderr, "kernel_launch: unexpected shapes (n_in %d out %d ws %zu need %zu)\n", n_in, out_size, ws_size, (size_t)WS_END); grid = -1; return; }
        int dev = 0, cus = 0, per_cu = 0;
        if (hipGetDevice(&dev) != hipSuccess || hipDeviceGetAttribute(&cus, hipDeviceAttributeMultiprocessorCount, dev) != hipSuccess) { grid = -1; return; }
        if (hipFuncSetAttribute((const void*)fwd_kernel, hipFuncAttributeMaxDynamicSharedMemorySize, LDS_BYTES) != hipSuccess) { fprintf(stderr, "kernel_launch: hipFuncSetAttribute failed\n"); grid = -1; return; }
        if (hipOccupancyMaxActiveBlocksPerMultiprocessor(&per_cu, (const void*)fwd_kernel, NTHR, LDS_BYTES) != hipSuccess || per_cu < 1) { fprintf(stderr, "kernel_launch: occupancy query says %d\n", per_cu); }
        (void)hipGetLastError();
        grid = cus;
    }
    if (grid < 0) return;
    if (hipMemsetAsync((char*)d_ws + WS_CTL, 0, CTL_ZERO_BYTES, stream) != hipSuccess) return;
    Args a{};
    for (int i = 0; i < 20; ++i) a.in[i] = (const float*)d_in[i];
    a.out = (float*)d_out; a.ws = (unsigned char*)d_ws;
#if MK_N_LAUNCHES == 1
    a.ph_lo = 0; a.ph_hi = N_PHASES;
    hipLaunchKernelGGL(fwd_kernel, dim3(grid), dim3(NTHR), LDS_BYTES, stream, a);
#else
    for (int p = 0; p < N_PHASES; ++p) { a.ph_lo = p; a.ph_hi = p + 1; hipLaunchKernelGGL(fwd_kernel, dim3(grid), dim3(NTHR), LDS_BYTES, stream, a); }
#endif
}
```

```cpp
#include <hip/hip_runtime.h>
#include <cstdio>
#include <cstdint>

#ifndef PROBE_PHASE
#define PROBE_PHASE (-1)
#define PROBE_REPS 2
#endif
#ifndef MK_N_LAUNCHES
#define MK_N_LAUNCHES 1
#endif

#define GAS __attribute__((address_space(1)))
#define LAS __attribute__((address_space(3)))
typedef unsigned short bf16;
typedef unsigned v4u __attribute__((ext_vector_type(4)));
typedef unsigned v2u __attribute__((ext_vector_type(2)));
typedef float f32x4 __attribute__((ext_vector_type(4)));
typedef float f32x2 __attribute__((ext_vector_type(2)));
typedef short bf16x8 __attribute__((ext_vector_type(8)));
typedef GAS unsigned gu32;

constexpr int D = 1024, NB = 8, SEQ = 2048, T = NB * SEQ, CTX = 256, TC = NB * CTX, TA = T + TC;
constexpr int HW = 512, HD = 128, NH = 4, FWID = 512, NG = 4, GD = 128;
constexpr int NPX = 5 * HW;
constexpr int NE = 32, TOPK = 4, DFF = 1024;
constexpr int SLOT_MAX = T * TOPK + NE * 256;
constexpr float NORM_EPS = 1e-6f;
constexpr int NWAVES = 8, NTHR = 512;

constexpr size_t MiB = 1u << 20;
constexpr size_t WS_CTL = 0, CTL_ZERO_BYTES = 1 * MiB;
constexpr size_t WS_MOD = 1 * MiB;
constexpr size_t WS_LB = WS_MOD + 9 * 6144 * 4;
constexpr size_t WS_ROUTE = WS_LB + 4096;
constexpr size_t WS_MG = 3 * MiB;
constexpr size_t WS_POS = 4 * MiB;
constexpr size_t WS_WINT = 12 * MiB;
constexpr size_t WS_WOUT = 19 * MiB;
constexpr size_t WS_DFT = 21 * MiB;
constexpr size_t WS_WB1 = 37 * MiB;
constexpr size_t WS_WB2 = 165 * MiB;
constexpr size_t WS_HMOD = 229 * MiB;
constexpr size_t WS_R1 = 265 * MiB;
constexpr size_t WS_PX = WS_R1;
constexpr size_t WS_PT = WS_PX + 90 * MiB;
constexpr size_t WS_OGLA = WS_PT + 32 * MiB;
constexpr size_t WS_EO = WS_OGLA + 64 * MiB;
constexpr size_t WS_HMP = WS_R1;
constexpr size_t WS_YS = WS_R1 + 72 * MiB;
constexpr size_t WS_MIX = WS_R1 + 218 * MiB;
constexpr size_t WS_X2 = WS_MIX + 32 * MiB;
constexpr size_t WS_HM = WS_X2 + 64 * MiB;
constexpr size_t WS_HH = WS_HM + 32 * MiB;
constexpr size_t WS_END = WS_HH + 144 * MiB;
static_assert(WS_END <= 1024 * MiB && WS_YS + 144 * MiB <= WS_MIX, "workspace map");
constexpr float SC_W = 64.0f, SC_HM = 16.0f, SC_HH = 4.0f;
constexpr int CW_CNT0 = 64;
#define NPASS ((PROBE_PHASE == 100 || PROBE_PHASE == 104 || PROBE_PHASE == 106 || PROBE_PHASE == 107 || PROBE_PHASE == 108) ? 2 : 1)
#define CW_CNT (CW_CNT0 + ((PROBE_PHASE == 6) ? 32 * (PROBE_REPS - 1) : 0) + ((PROBE_PHASE == 100 || PROBE_PHASE == 104 || PROBE_PHASE == 106 || PROBE_PHASE == 107 || PROBE_PHASE == 108) ? 32 : 0))
constexpr int CW_BAR = 4096;

constexpr int RING_BYTES = 131072;
constexpr int LDSCTL_OFF = RING_BYTES, MISC_OFF = LDSCTL_OFF + 320;
constexpr int LDS_BYTES = 147456;

#define LDS_WAIT() asm volatile("s_waitcnt lgkmcnt(0)" ::: "memory")
#define VM_WAIT() asm volatile("s_waitcnt vmcnt(0)" ::: "memory")
__device__ __forceinline__ unsigned f2bf(float f) { unsigned u = __builtin_bit_cast(unsigned, f); return (u + 0x7fffu + ((u >> 16) & 1u)) >> 16; }
__device__ __forceinline__ unsigned pk2(float lo, float hi) { return f2bf(lo) | (f2bf(hi) << 16); }
__device__ __forceinline__ float bf2f(unsigned short b) { return __builtin_bit_cast(float, ((unsigned)b) << 16); }
__device__ __forceinline__ float bflo(unsigned u) { return __builtin_bit_cast(float, u << 16); }
__device__ __forceinline__ float bfhi(unsigned u) { return __builtin_bit_cast(float, u & 0xffff0000u); }
__device__ __forceinline__ unsigned pk4_fp8(float a, float b, float c, float d) {
    a = __builtin_amdgcn_fmed3f(a, -448.f, 448.f); b = __builtin_amdgcn_fmed3f(b, -448.f, 448.f); c = __builtin_amdgcn_fmed3f(c, -448.f, 448.f); d = __builtin_amdgcn_fmed3f(d, -448.f, 448.f);
    int p = 0; p = __builtin_amdgcn_cvt_pk_fp8_f32(a, b, p, false); p = __builtin_amdgcn_cvt_pk_fp8_f32(c, d, p, true); return (unsigned)p; }
__device__ __forceinline__ float sigmoidf_(float x) { return __builtin_amdgcn_rcpf(1.0f + __expf(-x)); }

#define XB_TMO      128
#define XB_XCNT(j)  (256  + 64 * (j))
#define XB_XSUB(j)  (1280 + 64 * (j))
#define XB_XGEN(j)  (2304 + 64 * (j))
#define XB_TOP      3328
#define XB_TOPGEN   3392
#define XCD_BAR_WORDS 3456
#define XB_SPIN_CAP (1u << 18)
__device__ __forceinline__ unsigned xb_ld(unsigned* p)              { return __hip_atomic_load(p, __ATOMIC_RELAXED, __HIP_MEMORY_SCOPE_AGENT); }
__device__ __forceinline__ unsigned xb_add(unsigned* p, unsigned v) { return __hip_atomic_fetch_add(p, v, __ATOMIC_RELAXED, __HIP_MEMORY_SCOPE_AGENT); }
__device__ __forceinline__ unsigned xb_xcc_id() { return (unsigned)__builtin_amdgcn_s_getreg((3 << 11) | 20) & 0xFu; }
#define XB_SPIN(cond, bar) do { unsigned _sp = 0; while (cond) { __builtin_amdgcn_s_sleep(1); \
    if ((++_sp & 255u) == 0u) { if (xb_ld(&(bar)[XB_TMO])) break; if (_sp > XB_SPIN_CAP) { atomicAdd(&(bar)[XB_TMO], 1u); break; } } } } while (0)
struct XcdBarrier { unsigned* bar; unsigned x; volatile LAS unsigned* st; };
__device__ __forceinline__ XcdBarrier xcd_barrier_post(unsigned* bar, volatile LAS unsigned* st) {
    XcdBarrier b; b.bar = bar; b.x = xb_xcc_id(); b.st = st;
    if (threadIdx.x == 0) (void)xb_add(&bar[XB_XCNT(b.x)], 1u);
    return b;
}
__device__ __forceinline__ void xcd_barrier_complete(unsigned* bar, unsigned x, unsigned& nloc, unsigned& nx) {
    const unsigned G = gridDim.x * gridDim.y * gridDim.z;
    unsigned sum, cnt, mine, sp = 0u;
    for (;;) {
        sum = 0u; cnt = 0u; mine = 0u;
#pragma unroll
        for (unsigned j = 0; j < 16; ++j) { const unsigned c = xb_ld(&bar[XB_XCNT(j)]); sum += c; cnt += (c > 0u) ? 1u : 0u; mine = (j == x) ? c : mine; }
        if (sum == G) break;
        __builtin_amdgcn_s_sleep(1);
        if ((++sp & 255u) == 0u) { if (xb_ld(&bar[XB_TMO])) break; if (sp > XB_SPIN_CAP) { atomicAdd(&bar[XB_TMO], 1u); break; } }
    }
    nloc = mine > 0u ? mine : 1u; nx = cnt > 0u ? cnt : 1u;
}
__device__ __forceinline__ void xcd_barrier(const XcdBarrier& b) {
    asm volatile("s_waitcnt vmcnt(0)" ::: "memory");
    __syncthreads();
    if (threadIdx.x == 0) {
        unsigned* bar = b.bar;
        __builtin_amdgcn_s_waitcnt(0);
        unsigned nloc = b.st[0], nx = b.st[1];
        if (nloc == 0u) { xcd_barrier_complete(bar, b.x, nloc, nx); b.st[0] = nloc; b.st[1] = nx; }
        const unsigned old = xb_add(&bar[XB_XSUB(b.x)], 1u);
        const unsigned gen = old / nloc;
        if (old + 1u == (gen + 1u) * nloc) {
            __builtin_amdgcn_fence(__ATOMIC_RELEASE, "agent");
            asm volatile("s_waitcnt vmcnt(0)" ::: "memory");
            const unsigned og = xb_add(&bar[XB_TOP], 1u);
            const unsigned tg = og / nx;
            if (og + 1u == (tg + 1u) * nx) xb_add(&bar[XB_TOPGEN], 1u);
            else XB_SPIN(xb_ld(&bar[XB_TOPGEN]) == tg, bar);
            __builtin_amdgcn_fence(__ATOMIC_ACQUIRE, "agent");
            xb_add(&bar[XB_XGEN(b.x)], 1u);
            asm volatile("s_waitcnt vmcnt(0)" ::: "memory");
        } else {
            XB_SPIN(xb_ld(&bar[XB_XGEN(b.x)]) == gen, bar);
            __builtin_amdgcn_fence(__ATOMIC_ACQUIRE, "agent");
            asm volatile("s_waitcnt vmcnt(0)" ::: "memory");
        }
    }
    __syncthreads();
}

namespace pg8 {
constexpr int BM = 256, BK = 64, HALF = 128, HTB = HALF * BK * 2, NXCD = 8, WGM = 8;
__host__ __device__ __forceinline__ int lds_byte(int r, int c) { const int st = (r >> 4) * 2 + (c >> 5), rr = r & 15, cc = c & 31, ob = rr * 64 + cc * 2; return st * 1024 + (ob ^ (((ob >> 9) & 1) << 5)); }
__host__ __device__ __forceinline__ void stage_rc(int b, int& R, int& C) { const int st = b / 1024, sb = b % 1024, swz = sb ^ (((sb >> 9) & 1) << 5); R = (st >> 1) * 16 + swz / 64; C = (st & 1) * 32 + (swz % 64) / 2; }
__host__ __device__ __forceinline__ int perm32(int rho) { const int n = rho >> 4, i = rho & 15; return 8 * (i >> 2) + 4 * n + (i & 3); }

struct Unit { const char* a; const char* b; char* o; int i0, i1, i2, i3; };

__device__ __forceinline__ void tile_of(int L, int nM, int nN, int& pm, int& pn) {
    const int nwg = nM * nN; int wgid = L;
    { const int q = nwg / NXCD, r = nwg % NXCD, xcd = wgid % NXCD, off = wgid / NXCD; wgid = (xcd < r ? xcd * (q + 1) : r * (q + 1) + (xcd - r) * q) + off; }
    const int nig = WGM * nN, gid = wgid / nig, fm = gid * WGM, gsz = (nM - fm) < WGM ? (nM - fm) : WGM;
    pm = fm + ((wgid % nig) % gsz); pn = (wgid % nig) / gsz;
}
__device__ __forceinline__ unsigned cvt_pk_bf16(float lo, float hi) { unsigned r; asm volatile("v_cvt_pk_bf16_f32 %0, %1, %2" : "=v"(r) : "v"(lo), "v"(hi)); return r; }

typedef int v8i_t __attribute__((ext_vector_type(8)));
typedef int v4i_t __attribute__((ext_vector_type(4)));
template <class Epi, class Sched, bool FP8 = false>
__device__ __forceinline__ void gemm_phase(LAS unsigned char* lds, const int rowbytes, const size_t hsA, const size_t hsB, const Sched& S, const Epi& E) {
    const int tid = threadIdx.x, wid = __builtin_amdgcn_readfirstlane(tid >> 6), lane = tid & 63, wr = wid >> 2, wc = wid & 3, fr = lane & 15, fq = lane >> 4;
    const int nt = rowbytes / 128;
    unsigned voffA[2], voffB[2];
#pragma unroll
    for (int i = 0; i < 2; ++i) { int R, C; stage_rc(tid * 16 + i * 8192, R, C); const int Rb = Epi::PERM ? ((R & ~31) + perm32(R & 31)) : R;
        voffA[i] = (unsigned)(R * rowbytes + C * 2); voffB[i] = (unsigned)(Rb * rowbytes + C * 2); }
    const size_t kstep = (size_t)(BK * 2);
    const unsigned ldsw = (unsigned)wid * 1024u;
    const int aoff = lds_byte(wr * 64 + fr, fq * 8), boff = lds_byte(wc * 32 + fr, fq * 8);
#define PG8_SA(b, h) (((b) * 2 + (h)) * HTB)
#define PG8_SB(b, h) ((4 + (b) * 2 + (h)) * HTB)
#define PG8_STAGE(bufoff, gbase, voff) do { _Pragma("unroll") for (int _i = 0; _i < 2; ++_i) \
        __builtin_amdgcn_global_load_lds((const unsigned*)((const char*)(gbase) + (voff)[_i]), (LAS unsigned*)(lds + (bufoff) + ldsw + _i * 8192), 16, 0, 0); } while (0)
#define PG8_LD2(p) __builtin_shufflevector(*(const LAS v4i_t*)(p), *(const LAS v4i_t*)((p) + 1024), 0, 1, 2, 3, 4, 5, 6, 7)
#define PG8_LDA(dst, b, h) do { _Pragma("unroll") for (int m = 0; m < 4; ++m) dst[m] = PG8_LD2(lds + PG8_SA(b, h) + aoff + m * 2048); } while (0)
#define PG8_LDB(dst, b, h) do { _Pragma("unroll") for (int n = 0; n < 2; ++n) dst[n] = PG8_LD2(lds + PG8_SB(b, h) + boff + n * 2048); } while (0)
#define PG8_LO(x) __builtin_bit_cast(bf16x8, __builtin_shufflevector((x), (x), 0, 1, 2, 3))
#define PG8_HI(x) __builtin_bit_cast(bf16x8, __builtin_shufflevector((x), (x), 4, 5, 6, 7))
#define PG8_MMA(ai, bj, At, Bt) do { if constexpr (FP8) __builtin_amdgcn_sched_barrier(0); __builtin_amdgcn_s_setprio(1); _Pragma("unroll") for (int m = 0; m < 4; ++m) _Pragma("unroll") for (int n = 0; n < 2; ++n) { \
        if constexpr (FP8) { asm volatile("s_nop 1\n\tv_mfma_scale_f32_16x16x128_f8f6f4 %0, %1, %2, %0, %3, %3 op_sel_hi:[0,0,0]" : "+v"(acc[ai][bj][m][n]) : "v"(Bt[n]), "v"(At[m]), "v"(sc1)); } \
        else { acc[ai][bj][m][n] = __builtin_amdgcn_mfma_f32_16x16x32_bf16(PG8_LO(Bt[n]), PG8_LO(At[m]), acc[ai][bj][m][n], 0, 0, 0); \
               acc[ai][bj][m][n] = __builtin_amdgcn_mfma_f32_16x16x32_bf16(PG8_HI(Bt[n]), PG8_HI(At[m]), acc[ai][bj][m][n], 0, 0, 0); } } __builtin_amdgcn_s_setprio(0); if constexpr (FP8) __builtin_amdgcn_sched_barrier(0); } while (0)
#define PG8_WAIT_V(n) asm volatile("s_waitcnt vmcnt(" #n ")" ::: "memory")
#define PG8_WAIT_L(n) asm volatile("s_waitcnt lgkmcnt(" #n ")" ::: "memory")
#define PG8_BAR __builtin_amdgcn_s_barrier()
#define PG8_SCHED __builtin_amdgcn_sched_barrier(0)
    Unit cur, nxt; int ui = 0;
    if (!S.next(0, cur)) return;
    f32x4 acc[2][2][4][2];
#pragma unroll
    for (int a = 0; a < 2; ++a)
#pragma unroll
        for (int b = 0; b < 2; ++b)
#pragma unroll
            for (int m = 0; m < 4; ++m)
#pragma unroll
                for (int n = 0; n < 2; ++n) acc[a][b][m][n] = (f32x4){0.f, 0.f, 0.f, 0.f};
    v8i_t At[4], B0[2], B1[2];
    int sc1 = 0x7f7f7f7f; asm volatile("" : "+v"(sc1));
    const char* cA = cur.a; const char* cB = cur.b;
    PG8_STAGE(PG8_SB(0, 0), cB, voffB); PG8_STAGE(PG8_SB(0, 1), cB + hsB, voffB); PG8_STAGE(PG8_SA(0, 0), cA, voffA); PG8_STAGE(PG8_SA(0, 1), cA + hsA, voffA);
    if (wr == 1) PG8_BAR;
    PG8_WAIT_V(2); PG8_BAR;
    PG8_STAGE(PG8_SB(1, 0), cB + kstep, voffB); PG8_STAGE(PG8_SA(1, 0), cA + kstep, voffA); PG8_STAGE(PG8_SB(1, 1), cB + hsB + kstep, voffB);
    PG8_WAIT_V(6); PG8_BAR;
    for (;;) {
        const bool has_next = S.next(ui + 1, nxt);
        const char* nA = has_next ? nxt.a : cA; const char* nB = has_next ? nxt.b : cB;
#pragma nounroll
        for (int t = 0; t < nt; t += 2) {
            const bool last = (t == nt - 2);
            const char* a1 = cA + (size_t)(t + 1) * kstep;
            const char* a2 = last ? nA : cA + (size_t)(t + 2) * kstep; const char* b2 = last ? nB : cB + (size_t)(t + 2) * kstep;
            const char* a3 = a2 + kstep; const char* b3 = b2 + kstep;
            PG8_LDB(B0, 0, 0); PG8_LDB(B1, 0, 1); PG8_SCHED; PG8_LDA(At, 0, 0); PG8_STAGE(PG8_SA(1, 1), a1 + hsA, voffA);
            PG8_WAIT_V(8); PG8_WAIT_L(0); PG8_BAR; PG8_MMA(0, 0, At, B0); PG8_MMA(0, 1, At, B1); PG8_BAR; PG8_SCHED;
            PG8_LDA(At, 0, 1); PG8_STAGE(PG8_SB(0, 0), b2, voffB); PG8_STAGE(PG8_SB(0, 1), b2 + hsB, voffB); PG8_STAGE(PG8_SA(0, 0), a2, voffA);
            PG8_WAIT_V(8); PG8_WAIT_L(0); PG8_BAR; PG8_MMA(1, 0, At, B0); PG8_MMA(1, 1, At, B1); PG8_BAR; PG8_SCHED;
            PG8_LDB(B0, 1, 0); PG8_LDB(B1, 1, 1); PG8_SCHED; PG8_LDA(At, 1, 0); PG8_STAGE(PG8_SA(0, 1), a2 + hsA, voffA);
            PG8_WAIT_V(8); PG8_WAIT_L(0); PG8_BAR; PG8_MMA(0, 0, At, B0); PG8_MMA(0, 1, At, B1); PG8_BAR; PG8_SCHED;
            PG8_LDA(At, 1, 1); PG8_STAGE(PG8_SB(1, 0), b3, voffB); PG8_STAGE(PG8_SB(1, 1), b3 + hsB, voffB); PG8_STAGE(PG8_SA(1, 0), a3, voffA);
            PG8_WAIT_V(8); PG8_WAIT_L(0); PG8_BAR; PG8_MMA(1, 0, At, B0); PG8_MMA(1, 1, At, B1); PG8_BAR; PG8_SCHED;
        }
        if constexpr (FP8) asm volatile("s_nop 15\n\ts_nop 15" ::: "memory");
        if (wr == 0) PG8_BAR;
        E(acc, cur, wr, wc, fr, fq);
        if (!has_next) break;
#pragma unroll
        for (int a = 0; a < 2; ++a)
#pragma unroll
            for (int b = 0; b < 2; ++b)
#pragma unroll
                for (int m = 0; m < 4; ++m)
#pragma unroll
                    for (int n = 0; n < 2; ++n) acc[a][b][m][n] = (f32x4){0.f, 0.f, 0.f, 0.f};
        cur = nxt; cA = nA; cB = nB; ++ui;
        if (wr == 1) PG8_BAR;
    }
    PG8_WAIT_V(0);
    PG8_BAR;
#undef PG8_SA
#undef PG8_SB
#undef PG8_STAGE
#undef PG8_LDA
#undef PG8_LDB
#undef PG8_MMA
#undef PG8_LO
#undef PG8_HI
#undef PG8_LD2
#undef PG8_WAIT_V
#undef PG8_WAIT_L
#undef PG8_BAR
#undef PG8_SCHED
}

struct EpiStoreBf16 {
    static constexpr bool PERM = true;
    __device__ __forceinline__ void operator()(const f32x4 (&acc)[2][2][4][2], const Unit& u, int wr, int wc, int fr, int fq) const {
        bf16* base = (bf16*)u.o; const size_t ld = (size_t)u.i0;
        const int row0 = wr * 64 + fr, col0 = wc * 32 + 8 * fq;
#pragma unroll
        for (int ai = 0; ai < 2; ++ai)
#pragma unroll
            for (int m = 0; m < 4; ++m) { bf16* rowp = base + (size_t)(row0 + ai * HALF + m * 16) * ld + col0;
#pragma unroll
                for (int bj = 0; bj < 2; ++bj) { const f32x4 v0 = acc[ai][bj][m][0], v1 = acc[ai][bj][m][1];
                    v4u w; w.x = cvt_pk_bf16(v0[0], v0[1]); w.y = cvt_pk_bf16(v0[2], v0[3]); w.z = cvt_pk_bf16(v1[0], v1[1]); w.w = cvt_pk_bf16(v1[2], v1[3]);
                    *(v4u*)(rowp + bj * HALF) = w; } }
    }
};
struct EpiWout {
    static constexpr bool PERM = false;
    const float* x; const float* pos; const float* mod; float* x2;
    __device__ __forceinline__ void operator()(const f32x4 (&acc)[2][2][4][2], const Unit& u, int wr, int wc, int fr, int fq) const {
        const int row0 = u.i0 + wr * 64 + fr, col0 = u.i1 + wc * 32 + 4 * fq; const int b = u.i0 >> 11;
        f32x4 gv[2][2];
#pragma unroll
        for (int bj = 0; bj < 2; ++bj)
#pragma unroll
            for (int n = 0; n < 2; ++n) gv[bj][n] = *(const f32x4*)(mod + b * 6144 + 2 * D + col0 + bj * HALF + n * 16);
#pragma unroll
        for (int ai = 0; ai < 2; ++ai)
#pragma unroll
            for (int m = 0; m < 4; ++m) { const int t = row0 + ai * HALF + m * 16; const size_t ro = (size_t)t * D + col0; const size_t po = (size_t)(t & (SEQ - 1)) * D + col0;
#pragma unroll
                for (int bj = 0; bj < 2; ++bj)
#pragma unroll
                    for (int n = 0; n < 2; ++n) { const int co = bj * HALF + n * 16;
                        const f32x4 xv = *(const f32x4*)(x + ro + co), pv = *(const f32x4*)(pos + po + co);
                        *(f32x4*)(x2 + ro + co) = xv + pv + gv[bj][n] * acc[ai][bj][m][n]; } }
    }
};
struct EpiMoe1 {
    static constexpr bool PERM = true;
    const float* b1; unsigned char* hh;
    __device__ __forceinline__ void operator()(const f32x4 (&acc)[2][2][4][2], const Unit& u, int wr, int wc, int fr, int fq) const {
        const int row0 = u.i0 + wr * 64 + fr, col0 = u.i1 * HALF + wc * 32 + 8 * fq;
        const float* bb = b1 + (size_t)u.i2 * (2 * DFF) + col0;
        constexpr float inv = 1.0f / (SC_W * SC_HM);
        f32x4 bg[2], bl[2];
#pragma unroll
        for (int n = 0; n < 2; ++n) { bg[n] = *(const f32x4*)(bb + 4 * n); bl[n] = *(const f32x4*)(bb + DFF + 4 * n); }
#pragma unroll
        for (int ai = 0; ai < 2; ++ai)
#pragma unroll
            for (int m = 0; m < 4; ++m) { unsigned char* rowp = hh + (size_t)(row0 + ai * HALF + m * 16) * DFF + col0;
                float r[8];
#pragma unroll
                for (int n = 0; n < 2; ++n) { const f32x4 g = acc[ai][0][m][n] * inv + bg[n], l = acc[ai][1][m][n] * inv + bl[n];
#pragma unroll
                    for (int j = 0; j < 4; ++j) { const float ag = fminf(g[j], 7.0f), al = fminf(fmaxf(l[j], -7.0f), 7.0f);
                        r[4 * n + j] = SC_HH * ag * sigmoidf_(1.702f * ag) * (al + 1.0f); } }
                v2u w; w.x = pk4_fp8(r[0], r[1], r[2], r[3]); w.y = pk4_fp8(r[4], r[5], r[6], r[7]);
                *(v2u*)rowp = w; }
    }
};
struct EpiMoe2 {
    static constexpr bool PERM = true;
    const float* b2; bf16* ys;
    __device__ __forceinline__ void operator()(const f32x4 (&acc)[2][2][4][2], const Unit& u, int wr, int wc, int fr, int fq) const {
        const int row0 = u.i0 + wr * 64 + fr, col0 = u.i1 * BM + wc * 32 + 8 * fq;
        const float* bb = b2 + (size_t)u.i2 * D + col0;
        constexpr float inv = 1.0f / (SC_W * SC_HH);
        f32x4 bv[2][2];
#pragma unroll
        for (int bj = 0; bj < 2; ++bj)
#pragma unroll
            for (int n = 0; n < 2; ++n) bv[bj][n] = *(const f32x4*)(bb + bj * HALF + 4 * n);
#pragma unroll
        for (int ai = 0; ai < 2; ++ai)
#pragma unroll
            for (int m = 0; m < 4; ++m) { bf16* rowp = ys + (size_t)(row0 + ai * HALF + m * 16) * D + col0;
#pragma unroll
                for (int bj = 0; bj < 2; ++bj) { const f32x4 v0 = acc[ai][bj][m][0] * inv + bv[bj][0], v1 = acc[ai][bj][m][1] * inv + bv[bj][1];
                    v4u w; w.x = cvt_pk_bf16(v0[0], v0[1]); w.y = cvt_pk_bf16(v0[2], v0[3]); w.z = cvt_pk_bf16(v1[0], v1[1]); w.w = cvt_pk_bf16(v1[2], v1[3]);
                    *(v4u*)(rowp + bj * HALF) = w; } }
    }
};
}

struct Frame {
    LAS unsigned char* lds; volatile LAS unsigned* MISC; gu32* ctl;
    int tid, lane, wave, G, bid;
    const float* in[20]; float* out; unsigned char* ws;
};
enum { I_X = 0, I_C, I_CTX, I_CCTX, I_ADAW, I_ADAB, I_N1G, I_WIN, I_LB, I_GN, I_FNW, I_WOUT, I_N2G, I_RW, I_RB, I_W1, I_B1, I_W2, I_B2, I_FG };

__device__ __forceinline__ float wave_sum(float v) {
#pragma unroll
    for (int o = 1; o < 64; o <<= 1) v += __shfl_xor(v, o);
    return v;
}
__device__ __forceinline__ float wave_max(float v) {
#pragma unroll
    for (int o = 1; o < 64; o <<= 1) v = fmaxf(v, __shfl_xor(v, o));
    return v;
}

__device__ __forceinline__ void p0_transpose_item(const float* W, int ldw, int K, int nblk, bf16* WT, LAS float* scr, int item, int lane) {
    const int kb = item / nblk, nb = item % nblk, k0 = 64 * kb, n0 = 32 * nb;
#pragma unroll 8
    for (int i = 0; i < 32; ++i) { const int kk = 2 * i + (lane >> 5); scr[kk * 33 + (lane & 31)] = W[(size_t)(k0 + kk) * ldw + n0 + (lane & 31)]; }
    LDS_WAIT(); asm volatile("" ::: "memory");
    const int c = lane & 7;
#pragma unroll
    for (int j = 0; j < 4; ++j) { const int n = (lane >> 3) + 8 * j; const LAS float* s = scr + (8 * c) * 33 + n;
        v4u o; o.x = pk2(s[0 * 33], s[1 * 33]); o.y = pk2(s[2 * 33], s[3 * 33]); o.z = pk2(s[4 * 33], s[5 * 33]); o.w = pk2(s[6 * 33], s[7 * 33]);
        *(GAS v4u*)(WT + (size_t)(n0 + n) * K + k0 + 8 * c) = o; }
    LDS_WAIT(); asm volatile("" ::: "memory");
}
__device__ __forceinline__ void p0_transpose_item_fp8(const float* W, int ldw, int K, int nblk, unsigned char* WT, LAS float* scr, int item, int lane) {
    const int kb = item / nblk, nb = item % nblk, k0 = 64 * kb, n0 = 32 * nb;
#pragma unroll 8
    for (int i = 0; i < 32; ++i) { const int kk = 2 * i + (lane >> 5); scr[kk * 33 + (lane & 31)] = W[(size_t)(k0 + kk) * ldw + n0 + (lane & 31)]; }
    LDS_WAIT(); asm volatile("" ::: "memory");
    const int n = lane >> 1, hk = (lane & 1) * 32; const LAS float* sp = scr + hk * 33 + n;
    unsigned o[8];
#pragma unroll
    for (int q = 0; q < 8; ++q) o[q] = pk4_fp8(SC_W * sp[(4 * q) * 33], SC_W * sp[(4 * q + 1) * 33], SC_W * sp[(4 * q + 2) * 33], SC_W * sp[(4 * q + 3) * 33]);
    GAS v4u* dst = (GAS v4u*)(WT + (size_t)(n0 + n) * K + k0 + hk);
    dst[0] = (v4u){o[0], o[1], o[2], o[3]}; dst[1] = (v4u){o[4], o[5], o[6], o[7]};
    LDS_WAIT(); asm volatile("" ::: "memory");
}
__device__ __forceinline__ void p0_ada_task(Frame& F, int j) {
    LAS float* s = (LAS float*)F.lds;
    LAS float* red = (LAS float*)(F.lds + 9 * 1024 * 4);
    for (int i = F.tid; i < 9 * 1024; i += NTHR) { const int r = i >> 10, k = i & 1023; const float c = (r < 8) ? F.in[I_C][r * 1024 + k] : F.in[I_CCTX][k]; s[i] = c * sigmoidf_(c); }
    __syncthreads();
    const float* aw = F.in[I_ADAW] + (size_t)(128 * F.wave) * 6144 + 64 * j + F.lane;
    float acc[9];
#pragma unroll
    for (int r = 0; r < 9; ++r) acc[r] = 0.f;
    for (int k0 = 0; k0 < 128; k0 += 8) {
        float a[8];
#pragma unroll
        for (int u = 0; u < 8; ++u) a[u] = aw[(size_t)(k0 + u) * 6144];
#pragma unroll
        for (int u = 0; u < 8; ++u)
#pragma unroll
            for (int r = 0; r < 9; ++r) acc[r] += s[r * 1024 + 128 * F.wave + k0 + u] * a[u];
    }
#pragma unroll
    for (int r = 0; r < 9; ++r) red[(F.wave * 9 + r) * 64 + F.lane] = acc[r];
    __syncthreads();
    float* mod = (float*)(F.ws + WS_MOD);
    for (int i = F.tid; i < 9 * 64; i += NTHR) { const int r = i >> 6, l = i & 63; float v = F.in[I_ADAB][64 * j + l];
#pragma unroll
        for (int w = 0; w < 8; ++w) v += red[(w * 9 + r) * 64 + l];
        mod[r * 6144 + 64 * j + l] = v; }
    __syncthreads();
}
__device__ __forceinline__ void p0_prologue(Frame& F, int p0mask) {
    __syncthreads();
    if (p0mask & 1) {
    const int gtid = F.bid * NTHR + F.tid, NGT = F.G * NTHR;
    for (int j = F.bid; j < 96; j += F.G) p0_ada_task(F, j);
    if (F.bid == (96 % F.G)) { float* lb = (float*)(F.ws + WS_LB); for (int i = F.tid; i < 2 * HW; i += NTHR) { const float a = F.in[I_LB][i], b = F.in[I_LB][2 * HW + i]; lb[i] = 1.0f / (1.0f + __expf(b - a)); } }
    { float* pos = (float*)(F.ws + WS_POS);
      for (int i = gtid; i < SEQ * D; i += NGT) { const int l = i >> 10, c = i & 1023, q = c >> 8, j = c & 255;
          const float om = exp2f(-(float)j * (13.287712379549449f / 256.0f)); const float p = (float)((q < 2) ? (l >> 6) : (l & 63)); const float ang = p * om;
          pos[i] = (q & 1) ? cosf(ang) : sinf(ang); } }
    { float* mg = (float*)(F.ws + WS_MG);
      for (int i = gtid; i < NG * GD * 2 * GD; i += NGT) { const int j = i & 255, c = (i >> 8) & 127, g = i >> 15; const int jj = j & 127; const bool isS = j >= 128;
          const float* fw = F.in[I_FNW] + (size_t)g * GD * GD + jj; float acc = 0.f;
          for (int cp = 0; cp < GD; ++cp) { const int m = (c * cp) & 127; float sv, cv; sincospif((float)m * (1.0f / 64.0f), &sv, &cv); acc += (isS ? sv : cv) * fw[cp * GD]; }
          mg[i] = acc * 0.08838834764831845f; } }
    { bf16* dc = (bf16*)(F.ws + WS_DFT); bf16* ds = dc + (size_t)SEQ * SEQ;
      for (int i = gtid; i < SEQ * SEQ / 8; i += NGT) { const int k = i >> 8, l0 = (i & 255) * 8; float cv[8], sv[8];
#pragma unroll
          for (int u = 0; u < 8; ++u) { const int m = (k * (l0 + u)) & 2047; sincospif((float)m * (1.0f / 1024.0f), &sv[u], &cv[u]); cv[u] *= 0.022097086912079608f; sv[u] *= 0.022097086912079608f; }
          v4u a, b; a.x = pk2(cv[0], cv[1]); a.y = pk2(cv[2], cv[3]); a.z = pk2(cv[4], cv[5]); a.w = pk2(cv[6], cv[7]);
          b.x = pk2(sv[0], sv[1]); b.y = pk2(sv[2], sv[3]); b.z = pk2(sv[4], sv[5]); b.w = pk2(sv[6], sv[7]);
          *(v4u*)(dc + (size_t)k * SEQ + l0) = a; *(v4u*)(ds + (size_t)k * SEQ + l0) = b; } }
    }
    if (!(p0mask & 2)) return;
    LAS float* scr = (LAS float*)(F.lds + F.wave * 16384);
    const int gw = F.bid * NWAVES + F.wave, NGW = F.G * NWAVES;
    constexpr int I_IN = 16 * (NPX / 32), I_OUT = 16 * 32, I_1 = 16 * 64, I_2 = 16 * 32;
    constexpr int NITEMS = I_IN + I_OUT + NE * I_1 + NE * I_2;
    for (int it = gw; it < NITEMS; it += NGW) {
        int r = it;
        if (r < I_IN) { p0_transpose_item(F.in[I_WIN], 3072, D, NPX / 32, (bf16*)(F.ws + WS_WINT), scr, r, F.lane); continue; } r -= I_IN;
        if (r < I_OUT) { p0_transpose_item(F.in[I_WOUT], D, D, 32, (bf16*)(F.ws + WS_WOUT), scr, r, F.lane); continue; } r -= I_OUT;
        if (r < NE * I_1) { const int e = r / I_1; p0_transpose_item_fp8(F.in[I_W1] + (size_t)e * D * 2 * DFF, 2 * DFF, D, 64, F.ws + WS_WB1 + (size_t)e * 2 * DFF * D, scr, r % I_1, F.lane); continue; } r -= NE * I_1;
        { const int e = r / I_2; p0_transpose_item_fp8(F.in[I_W2] + (size_t)e * DFF * D, D, DFF, 32, F.ws + WS_WB2 + (size_t)e * D * DFF, scr, r % I_2, F.lane); }
    }
}

__device__ __forceinline__ void p1_row(Frame& F, int t) {
    const float* mod = (const float*)(F.ws + WS_MOD); const float* g1 = F.in[I_N1G];
    const bool lat = t < T; const int b = lat ? (t >> 11) : 8;
    const GAS f32x4* xr = (const GAS f32x4*)(lat ? F.in[I_X] + (size_t)t * D : F.in[I_CTX] + (size_t)(t - T) * D) + F.lane;
    const GAS f32x4* pr = (const GAS f32x4*)((const float*)(F.ws + WS_POS) + (size_t)(t & (SEQ - 1)) * D) + F.lane;
    f32x4 v[4]; float ss = 0.f;
#pragma unroll
    for (int j = 0; j < 4; ++j) { v[j] = xr[64 * j]; if (lat) v[j] = v[j] + pr[64 * j]; ss += (v[j].x * v[j].x + v[j].y * v[j].y) + (v[j].z * v[j].z + v[j].w * v[j].w); }
    const float rinv = 1.0f / sqrtf(wave_sum(ss) * (1.0f / D) + NORM_EPS);
    GAS unsigned long long* o8 = (GAS unsigned long long*)((bf16*)(F.ws + WS_HMOD) + (size_t)t * D) + F.lane;
#pragma unroll
    for (int j = 0; j < 4; ++j) { const int c = 4 * F.lane + 256 * j;
        const f32x4 g = *(const f32x4*)(g1 + c), sh = *(const f32x4*)(mod + b * 6144 + c), sc = *(const f32x4*)(mod + b * 6144 + D + c);
        const f32x4 h = v[j] * rinv * g * (sc + 1.0f) + sh;
        o8[64 * j] = (unsigned long long)pk2(h.x, h.y) | ((unsigned long long)pk2(h.z, h.w) << 32); }
}
__device__ __forceinline__ void p1_fold_task(Frame& F, int task) {
    const int kb = task & 15, pq = (task >> 4) & 1, g = task >> 5, k0 = 64 * kb;
    LAS float* wt = (LAS float*)F.lds;
    LAS float* mh = (LAS float*)(F.lds + 64 * 129 * 4);
    const float* mg = (const float*)(F.ws + WS_MG) + (size_t)g * GD * 256 + pq * 128;
    for (int i = F.tid; i < 64 * 128; i += NTHR) { const int kk = i >> 7, c = i & 127; wt[kk * 129 + c] = F.in[I_WIN][(size_t)(k0 + kk) * 3072 + NPX + g * GD + c]; }
    for (int i = F.tid; i < 128 * 128; i += NTHR) { const int c = i >> 7, j = i & 127; mh[i] = mg[c * 256 + j]; }
    __syncthreads();
    const int kk = F.tid & 63, jg = F.tid >> 6;
    float acc[16];
#pragma unroll
    for (int i = 0; i < 16; ++i) acc[i] = 0.f;
    for (int c = 0; c < 128; ++c) { const float w = wt[kk * 129 + c]; const LAS f32x4* m4 = (const LAS f32x4*)(mh + c * 128 + jg * 16);
#pragma unroll
        for (int q = 0; q < 4; ++q) { const f32x4 mv = m4[q]; acc[4 * q] += w * mv.x; acc[4 * q + 1] += w * mv.y; acc[4 * q + 2] += w * mv.z; acc[4 * q + 3] += w * mv.w; } }
    bf16* wf = (bf16*)(F.ws + WS_WINT) + (size_t)NPX * D;
#pragma unroll
    for (int i = 0; i < 16; ++i) wf[(size_t)(pq * 512 + g * GD + jg * 16 + i) * D + k0 + kk] = (bf16)f2bf(acc[i]);
    __syncthreads();
}
__device__ __forceinline__ void p1_phase(Frame& F) {
    for (int task = F.bid; task < 128; task += F.G) p1_fold_task(F, task);
    const int gw = F.bid * NWAVES + F.wave, NGW = F.G * NWAVES;
    for (int t = gw; t < TA; t += NGW) p1_row(F, t);
}

struct SchedInproj {
    int G, c; const char* hmod; const char* wint; char* px; char* pt;
    __device__ __forceinline__ bool next(int i, pg8::Unit& u) const {
        const int L = i * G + c;
        if (L < 720) { int pm, pn; pg8::tile_of(L, 72, 10, pm, pn);
            u.a = hmod + (size_t)pm * 256 * D * 2; u.b = wint + (size_t)pn * 256 * D * 2; u.o = px + ((size_t)pm * 256 * NPX + (size_t)pn * 256) * 2; u.i0 = NPX; u.i1 = u.i2 = u.i3 = 0; return true; }
        if (L < 976) { int pm, pn; pg8::tile_of(L - 720, 4, 64, pm, pn);
            const int pq = pm >> 1, c0 = (pm & 1) * 256, b = pn >> 3, l0 = (pn & 7) * 256;
            u.a = wint + (size_t)(NPX + pm * 256) * D * 2; u.b = hmod + (size_t)pn * 256 * D * 2;
            u.o = pt + ((((size_t)(pq * 8 + b) * 512 + c0) * SEQ) + l0) * 2; u.i0 = SEQ; u.i1 = u.i2 = u.i3 = 0; return true; }
        return false;
    }
};
namespace gla {
constexpr int GP = 272, GP64 = 144;
constexpr int L_QI = 0, L_KI = L_QI + 64 * GP, L_KIT = L_KI + 64 * GP, L_VT = L_KIT + 128 * GP64, L_TT = L_VT + 32 * GP64, L_P = L_TT + 32 * GP, L_TOT = L_P + 64 * GP64, L_C = L_TOT + 4096, L_END = L_C + 1024;
static_assert(L_END <= RING_BYTES, "gla lds");
}
#define GLA_MFMA(a, b, c) __builtin_amdgcn_mfma_f32_16x16x32_bf16((a), (b), (c), 0, 0, 0)
__device__ __forceinline__ void p3_gla_chunked(Frame& F, int chain) {
    using namespace gla;
    const int vq = chain & 3, dir = (chain >> 2) & 1, h = (chain >> 3) & 3, b = chain >> 5;
    LAS unsigned char* L = F.lds;
    const bf16* px = (const bf16*)(F.ws + WS_PX);
    const float* lbp = (const float*)(F.ws + WS_LB) + dir * HW + h * HD;
    float* og = (float*)(F.ws + WS_OGLA) + (size_t)dir * T * HW;
    const int lane = F.lane, w = F.wave, g = lane >> 4, li = lane & 15;
    const int zcol = 3 * HW + dir * HW + h * HD + 2 * lane, qcol = h * HD + 2 * lane, vcol = HW + h * HD + vq * 32 + (F.tid & 7) * 4;
    const float lb0 = lbp[2 * lane], lb1 = lbp[2 * lane + 1];
    f32x4 S0 = (f32x4){0.f, 0.f, 0.f, 0.f}, S1 = (f32x4){0.f, 0.f, 0.f, 0.f};
    constexpr int NBLK = (CTX + SEQ) / 64;
    unsigned zr[8], qr[8]; v2u vr;
#define GLA_ROWBASE(blk) (((blk) < CTX / 64) ? (size_t)(T + b * CTX + ((dir == 0) ? (blk) * 64 : (CTX - 64 - (blk) * 64))) : (size_t)(b * SEQ + ((dir == 0) ? ((blk) - CTX / 64) * 64 : (SEQ - 64 - ((blk) - CTX / 64) * 64))))
#define GLA_LOAD(blk) do { const size_t rb_ = GLA_ROWBASE(blk); const bool lat_ = (blk) >= CTX / 64; \
        _Pragma("unroll") for (int i = 0; i < 8; ++i) { const int tl = 8 * w + i; const bf16* pr = px + (rb_ + (dir ? 63 - tl : tl)) * NPX; zr[i] = *(const unsigned*)(pr + zcol); qr[i] = lat_ ? *(const unsigned*)(pr + qcol) : 0u; } \
        { const int tl = F.tid >> 3; vr = *(const v2u*)(px + (rb_ + (dir ? 63 - tl : tl)) * NPX + vcol); } } while (0)
    GLA_LOAD(0);
    for (int blk = 0; blk < NBLK; ++blk) {
        const bool lat = blk >= CTX / 64;
        const size_t rowbase = GLA_ROWBASE(blk);
        float c0[8], c1[8], k0[8], k1[8], q0[8], q1[8];
        { float a0 = 0.f, a1 = 0.f;
#pragma unroll
          for (int i = 0; i < 8; ++i) { const float f0 = lb0 + (1.0f - lb0) * sigmoidf_(bflo(zr[i])), f1 = lb1 + (1.0f - lb1) * sigmoidf_(bfhi(zr[i]));
              a0 += __logf(f0); a1 += __logf(f1); c0[i] = a0; c1[i] = a1; k0[i] = 1.0f - f0; k1[i] = 1.0f - f1; q0[i] = bflo(qr[i]); q1[i] = bfhi(qr[i]); }
          *(LAS f32x2*)(L + L_TOT + (w * 128 + 2 * lane) * 4) = (f32x2){a0, a1}; }
        const v2u vcur = vr;
        if (blk + 1 < NBLK) GLA_LOAD(blk + 1);
        __syncthreads();
        { float pre0 = 0.f, pre1 = 0.f, br0 = 0.f, br1 = 0.f, bl0 = 0.f, bl1 = 0.f;
#pragma unroll
          for (int t2 = 0; t2 < 8; ++t2) { const f32x2 tt = *(const LAS f32x2*)(L + L_TOT + (t2 * 128 + 2 * lane) * 4);
              if (t2 < w) { pre0 += tt.x; pre1 += tt.y; } if (t2 < 4) { br0 += tt.x; br1 += tt.y; } bl0 += tt.x; bl1 += tt.y; }
          unsigned kp0[4], kp1[4];
#pragma unroll
          for (int i = 0; i < 8; i += 2) {
              const float ea0 = __expf(pre0 + c0[i] - br0), ea1 = __expf(pre1 + c1[i] - br1), eb0 = __expf(pre0 + c0[i + 1] - br0), eb1 = __expf(pre1 + c1[i + 1] - br1);
              const float ka0 = k0[i] * __builtin_amdgcn_rcpf(ea0), ka1 = k1[i] * __builtin_amdgcn_rcpf(ea1), kb0 = k0[i + 1] * __builtin_amdgcn_rcpf(eb0), kb1 = k1[i + 1] * __builtin_amdgcn_rcpf(eb1);
              const int t = 8 * w + i;
              if (lat) { *(LAS unsigned*)(L + L_QI + t * GP + 4 * lane) = pg8::cvt_pk_bf16(q0[i] * ea0, q1[i] * ea1); *(LAS unsigned*)(L + L_QI + (t + 1) * GP + 4 * lane) = pg8::cvt_pk_bf16(q0[i + 1] * eb0, q1[i + 1] * eb1);
                         *(LAS unsigned*)(L + L_KI + t * GP + 4 * lane) = pg8::cvt_pk_bf16(ka0, ka1); *(LAS unsigned*)(L + L_KI + (t + 1) * GP + 4 * lane) = pg8::cvt_pk_bf16(kb0, kb1); }
              kp0[i >> 1] = pg8::cvt_pk_bf16(ka0, kb0); kp1[i >> 1] = pg8::cvt_pk_bf16(ka1, kb1); }
          *(LAS v4u*)(L + L_KIT + (2 * lane) * GP64 + w * 16) = (v4u){kp0[0], kp0[1], kp0[2], kp0[3]};
          *(LAS v4u*)(L + L_KIT + (2 * lane + 1) * GP64 + w * 16) = (v4u){kp1[0], kp1[1], kp1[2], kp1[3]};
          if (w == 0) { *(LAS f32x2*)(L + L_C + 2 * lane * 4) = (f32x2){__expf(br0), __expf(br1)}; *(LAS f32x2*)(L + L_C + (128 + 2 * lane) * 4) = (f32x2){__expf(bl0 - br0), __expf(bl1 - br1)}; } }
        { const int tl = F.tid >> 3, c4 = (F.tid & 7) * 4;
          *(LAS unsigned short*)(L + L_VT + (c4 + 0) * GP64 + tl * 2) = (unsigned short)(vcur.x & 0xffffu); *(LAS unsigned short*)(L + L_VT + (c4 + 1) * GP64 + tl * 2) = (unsigned short)(vcur.x >> 16);
          *(LAS unsigned short*)(L + L_VT + (c4 + 2) * GP64 + tl * 2) = (unsigned short)(vcur.y & 0xffffu); *(LAS unsigned short*)(L + L_VT + (c4 + 3) * GP64 + tl * 2) = (unsigned short)(vcur.y >> 16); }
        __syncthreads();
        const f32x4 c1v = *(const LAS f32x4*)(L + L_C + (16 * w + 4 * g) * 4), c2v = *(const LAS f32x4*)(L + L_C + (128 + 16 * w + 4 * g) * 4);
        const f32x4 T0 = S0 * c1v, T1 = S1 * c1v;
        if (lat) {
            *(LAS v2u*)(L + L_TT + li * GP + (16 * w + 4 * g) * 2) = (v2u){pg8::cvt_pk_bf16(T0.x, T0.y), pg8::cvt_pk_bf16(T0.z, T0.w)};
            *(LAS v2u*)(L + L_TT + (16 + li) * GP + (16 * w + 4 * g) * 2) = (v2u){pg8::cvt_pk_bf16(T1.x, T1.y), pg8::cvt_pk_bf16(T1.z, T1.w)};
            const int ti = w & 3;
#pragma unroll
            for (int jj = 0; jj < 2; ++jj) { const int tj = 2 * (w >> 2) + jj; f32x4 acc = (f32x4){0.f, 0.f, 0.f, 0.f};
                if (tj <= ti) {
#pragma unroll
                    for (int ks = 0; ks < 4; ++ks) { const bf16x8 a = *(const LAS bf16x8*)(L + L_QI + (16 * ti + li) * GP + ks * 64 + g * 16), bb = *(const LAS bf16x8*)(L + L_KI + (16 * tj + li) * GP + ks * 64 + g * 16); acc = GLA_MFMA(a, bb, acc); } }
#pragma unroll
                for (int r = 0; r < 4; ++r) { const bool keep = (tj < ti) || (tj == ti && li <= 4 * g + r); const float val = keep ? acc[r] : 0.0f;
                    *(LAS unsigned short*)(L + L_P + (16 * ti + 4 * g + r) * GP64 + (16 * tj + li) * 2) = (unsigned short)f2bf(val); } }
        }
        __syncthreads();
        if (lat) { const int ti = w & 3, vj = w >> 2; f32x4 acc = (f32x4){0.f, 0.f, 0.f, 0.f};
#pragma unroll
            for (int ks = 0; ks < 2; ++ks) { const bf16x8 a = *(const LAS bf16x8*)(L + L_P + (16 * ti + li) * GP64 + ks * 64 + g * 16), bb = *(const LAS bf16x8*)(L + L_VT + (16 * vj + li) * GP64 + ks * 64 + g * 16); acc = GLA_MFMA(a, bb, acc); }
#pragma unroll
            for (int ks = 0; ks < 4; ++ks) { const bf16x8 a = *(const LAS bf16x8*)(L + L_QI + (16 * ti + li) * GP + ks * 64 + g * 16), bb = *(const LAS bf16x8*)(L + L_TT + (16 * vj + li) * GP + ks * 64 + g * 16); acc = GLA_MFMA(a, bb, acc); }
#pragma unroll
            for (int r = 0; r < 4; ++r) { const int tl = 16 * ti + 4 * g + r; og[(rowbase + (dir ? 63 - tl : tl)) * HW + h * HD + vq * 32 + 16 * vj + li] = acc[r]; } }
        { f32x4 a0 = T0, a1 = T1;
#pragma unroll
          for (int ks = 0; ks < 2; ++ks) { const bf16x8 a = *(const LAS bf16x8*)(L + L_KIT + (16 * w + li) * GP64 + ks * 64 + g * 16);
              const bf16x8 b0 = *(const LAS bf16x8*)(L + L_VT + li * GP64 + ks * 64 + g * 16), b1 = *(const LAS bf16x8*)(L + L_VT + (16 + li) * GP64 + ks * 64 + g * 16);
              a0 = GLA_MFMA(a, b0, a0); a1 = GLA_MFMA(a, b1, a1); }
          S0 = a0 * c2v; S1 = a1 * c2v; }
        __syncthreads();
    }
#undef GLA_LOAD
#undef GLA_ROWBASE
}
struct SchedFourier {
    int G, c; const char* dft; const char* pt; char* eo;
    __device__ __forceinline__ bool next(int i, pg8::Unit& u) const {
        const int L = i * G + c; if (L >= 256) return false;
        const int b = L & 7, r = L >> 3, kt = r >> 2, pn = r & 3, pq = pn >> 1;
        u.a = dft + ((size_t)pq * SEQ * SEQ + (size_t)kt * 256 * SEQ) * 2;
        u.b = pt + (((size_t)(pq * 8 + b) * 512 + (pn & 1) * 256) * SEQ) * 2;
        u.o = eo + (((size_t)b * SEQ + kt * 256) * D + pn * 256) * 2; u.i0 = D; u.i1 = u.i2 = u.i3 = 0; return true;
    }
};
__device__ __forceinline__ void p3c_row(Frame& F, int t) {
    const float* o0 = (const float*)(F.ws + WS_OGLA) + (size_t)t * HW + 8 * F.lane; const float* o1 = o0 + (size_t)T * HW;
    const f32x4 a0 = *(const f32x4*)o0, a1 = *(const f32x4*)(o0 + 4), b0 = *(const f32x4*)o1, b1 = *(const f32x4*)(o1 + 4);
    float o[8] = {a0.x + b0.x, a0.y + b0.y, a0.z + b0.z, a0.w + b0.w, a1.x + b1.x, a1.y + b1.y, a1.z + b1.z, a1.w + b1.w};
    float ss = 0.f;
#pragma unroll
    for (int i = 0; i < 8; ++i) ss += o[i] * o[i];
    ss += __shfl_xor(ss, 1); ss += __shfl_xor(ss, 2); ss += __shfl_xor(ss, 4); ss += __shfl_xor(ss, 8);
    const float rinv = 1.0f / sqrtf(ss * (1.0f / HD) + NORM_EPS);
    const float* gn = F.in[I_GN] + ((8 * F.lane) & 127);
    const v4u gz = *(const v4u*)((const bf16*)(F.ws + WS_PX) + (size_t)t * NPX + 2 * HW + 8 * F.lane);
    const unsigned gg[4] = {gz.x, gz.y, gz.z, gz.w};
    float hx[8];
#pragma unroll
    for (int u = 0; u < 4; ++u) { hx[2 * u] = o[2 * u] * rinv * gn[2 * u] * sigmoidf_(bflo(gg[u])); hx[2 * u + 1] = o[2 * u + 1] * rinv * gn[2 * u + 1] * sigmoidf_(bfhi(gg[u])); }
    bf16* mix = (bf16*)(F.ws + WS_MIX) + (size_t)t * D;
    v4u w; w.x = pk2(hx[0], hx[1]); w.y = pk2(hx[2], hx[3]); w.z = pk2(hx[4], hx[5]); w.w = pk2(hx[6], hx[7]);
    *(v4u*)(mix + 8 * F.lane) = w;
    const bf16* eo = (const bf16*)(F.ws + WS_EO) + (size_t)t * D + 8 * F.lane;
    const v4u e = *(const v4u*)eo, q = *(const v4u*)(eo + 512);
    v4u f; f.x = pk2(bflo(e.x) - bflo(q.x), bfhi(e.x) - bfhi(q.x)); f.y = pk2(bflo(e.y) - bflo(q.y), bfhi(e.y) - bfhi(q.y));
    f.z = pk2(bflo(e.z) - bflo(q.z), bfhi(e.z) - bfhi(q.z)); f.w = pk2(bflo(e.w) - bflo(q.w), bfhi(e.w) - bfhi(q.w));
    *(v4u*)(mix + HW + 8 * F.lane) = f;
}
struct SchedWout {
    int G, c; const char* mix; const char* wout;
    __device__ __forceinline__ bool next(int i, pg8::Unit& u) const {
        const int L = i * G + c; if (L >= 256) return false;
        int pm, pn; pg8::tile_of(L, 64, 4, pm, pn);
        u.a = mix + (size_t)pm * 256 * D * 2; u.b = wout + (size_t)pn * 256 * D * 2; u.o = nullptr; u.i0 = pm * 256; u.i1 = pn * 256; u.i2 = u.i3 = 0; return true;
    }
};
__device__ __forceinline__ void p5a_phase(Frame& F, int cw_cnt) {
    LAS float* wrT = (LAS float*)F.lds;
    volatile LAS unsigned* lcnt = F.MISC + 16;
    volatile LAS unsigned* lbase = F.MISC + 48;
    const float* rw = F.in[I_RW];
    for (int i = F.tid; i < D * NE; i += NTHR) { const int k = i >> 5, e = i & 31; wrT[e * 1024 + k] = rw[i]; }
    const float* mod = (const float*)(F.ws + WS_MOD); const float* g2 = F.in[I_N2G];
    int* tok_e = (int*)(F.ws + WS_ROUTE); int* tok_pos = tok_e + T * 4; float* tok_w = (float*)(tok_pos + T * 4);
    for (int base = F.bid * 64; base < T; base += F.G * 64) {
        if (F.tid < 32) lcnt[F.tid] = 0u;
        __syncthreads();
        int my_e = 0; unsigned my_rank = 0; float my_w = 0.f;
#pragma unroll 1
        for (int i = 0; i < 8; ++i) {
            const int t = base + F.wave * 8 + i; const int b = t >> 11;
            const GAS f32x4* xr = (const GAS f32x4*)((const float*)(F.ws + WS_X2) + (size_t)t * D) + F.lane;
            f32x4 v[4]; float ss = 0.f;
#pragma unroll
            for (int j = 0; j < 4; ++j) { v[j] = xr[64 * j]; ss += (v[j].x * v[j].x + v[j].y * v[j].y) + (v[j].z * v[j].z + v[j].w * v[j].w); }
            const float rinv = 1.0f / sqrtf(wave_sum(ss) * (1.0f / D) + NORM_EPS);
            GAS unsigned* o4 = (GAS unsigned*)(F.ws + WS_HM + (size_t)t * D) + F.lane;
#pragma unroll
            for (int j = 0; j < 4; ++j) { const int c = 4 * F.lane + 256 * j;
                const f32x4 g = *(const f32x4*)(g2 + c), sh = *(const f32x4*)(mod + b * 6144 + 3 * D + c), sc = *(const f32x4*)(mod + b * 6144 + 4 * D + c);
                v[j] = v[j] * rinv * g * (sc + 1.0f) + sh;
                o4[64 * j] = pk4_fp8(SC_HM * v[j].x, SC_HM * v[j].y, SC_HM * v[j].z, SC_HM * v[j].w); }
            float acc[32];
#pragma unroll
            for (int e = 0; e < 32; ++e) { float a = 0.f;
                if ((e & 3) == 0) asm volatile("" ::: "memory");
#pragma unroll
                for (int j = 0; j < 4; ++j) { const f32x4 w = *(const LAS f32x4*)(wrT + e * 1024 + 4 * F.lane + 256 * j); a += v[j].x * w.x + v[j].y * w.y + v[j].z * w.z + v[j].w * w.w; }
                acc[e] = a; }
#define P5_HALVE(N, MASK) _Pragma("unroll") for (int j = 0; j < N; ++j) { const bool hi = (F.lane & MASK) != 0; const float keep = hi ? acc[j + N] : acc[j]; const float send = hi ? acc[j] : acc[j + N]; acc[j] = keep + __shfl_xor(send, MASK); }
            P5_HALVE(16, 32) P5_HALVE(8, 16) P5_HALVE(4, 8) P5_HALVE(2, 4) P5_HALVE(1, 2)
#undef P5_HALVE
            float lg = acc[0] + __shfl_xor(acc[0], 1);
            const int e_me = F.lane >> 1;
            lg += F.in[I_RB][e_me];
            float tv0, tv1, tv2, tv3; int te0, te1, te2, te3;
#define P5_TOP(TV, TE) { const float m = wave_max(lg); const unsigned long long bal = __ballot(lg == m); const int ln = __ffsll((long long)bal) - 1; TE = ln >> 1; TV = m; if (e_me == TE) lg = -3.0e38f; }
            P5_TOP(tv0, te0) P5_TOP(tv1, te1) P5_TOP(tv2, te2) P5_TOP(tv3, te3)
#undef P5_TOP
            const float e1 = __expf(tv1 - tv0), e2 = __expf(tv2 - tv0), e3 = __expf(tv3 - tv0); const float inv = 1.0f / (1.0f + e1 + e2 + e3);
            if ((F.lane >> 2) == i && F.lane < 32) { const int k = F.lane & 3; my_e = te0; my_w = inv;
                if (k == 1) { my_e = te1; my_w = e1 * inv; } if (k == 2) { my_e = te2; my_w = e2 * inv; } if (k == 3) { my_e = te3; my_w = e3 * inv; } }
        }
        if (F.lane < 32) my_rank = __hip_atomic_fetch_add((LAS unsigned*)lcnt + my_e, 1u, __ATOMIC_RELAXED, __HIP_MEMORY_SCOPE_WORKGROUP);
        __syncthreads();
        if (F.tid < 32) lbase[F.tid] = __hip_atomic_fetch_add((unsigned*)(F.ctl + cw_cnt) + F.tid, lcnt[F.tid], __ATOMIC_RELAXED, __HIP_MEMORY_SCOPE_AGENT);
        __syncthreads();
        if (F.lane < 32) { const int t = base + F.wave * 8 + (F.lane >> 2); const int idx = t * 4 + (F.lane & 3);
            tok_e[idx] = my_e; tok_pos[idx] = (int)(lbase[my_e] + my_rank); tok_w[idx] = my_w; }
        __syncthreads();
    }
}
__device__ __forceinline__ void moe_offsets(Frame& F, volatile LAS unsigned* boff) {
    if (F.tid == 0) { unsigned acc = 0; for (int e = 0; e < NE; ++e) { boff[e] = acc; acc += (((const unsigned*)(F.ctl + CW_CNT))[e] + 255u) >> 8; } boff[NE] = acc; }
    __syncthreads();
}
__device__ __forceinline__ void p5c_phase(Frame& F) {
    volatile LAS unsigned* boff = F.MISC + 16;
    moe_offsets(F, boff);
    const int* tok_e = (const int*)(F.ws + WS_ROUTE); const int* tok_pos = tok_e + T * 4; int* tok_slot = (int*)(F.ws + WS_ROUTE) + 3 * T * 4;
    const int gw = F.bid * NWAVES + F.wave, NGW = F.G * NWAVES;
    for (int t = gw; t < T; t += NGW) {
        const v4u r0 = *((const GAS v4u*)(F.ws + WS_HM + (size_t)t * D) + F.lane);
#pragma unroll
        for (int k = 0; k < 4; ++k) { const int e = tok_e[t * 4 + k]; const int slot = (int)(boff[e] * 256u) + tok_pos[t * 4 + k];
            *((GAS v4u*)(F.ws + WS_HMP + (size_t)slot * D) + F.lane) = r0;
            if (F.lane == 0) tok_slot[t * 4 + k] = slot; }
    }
}
template <int NPN, int MODE>
struct SchedMoe {
    int r, nmem, x; unsigned n0, n1, n2, n3, b0, b1, b2, b3; const char* A; const char* B;
    __device__ __forceinline__ void init(Frame& F, volatile LAS unsigned* boff, const char* A_, const char* B_) {
        x = F.bid & 7; r = F.bid >> 3; nmem = (F.G + 7 - x) / 8; A = A_; B = B_;
        b0 = boff[x]; n0 = boff[x + 1] - b0; b1 = boff[x + 8]; n1 = boff[x + 9] - b1; b2 = boff[x + 16]; n2 = boff[x + 17] - b2; b3 = boff[x + 24]; n3 = boff[x + 25] - b3;
        if ((F.G & 7) != 0) { nmem = 0; }
    }
    __device__ __forceinline__ bool next(int i, pg8::Unit& u) const {
        if (nmem == 0) return false;
        const unsigned j = (unsigned)(i * nmem + r); unsigned blk = j / NPN; const int pn = (int)(j % NPN);
        int e; unsigned gb;
        if (blk < n0) { e = x; gb = b0 + blk; }
        else { blk -= n0;
            if (blk < n1) { e = x + 8; gb = b1 + blk; }
            else { blk -= n1;
                if (blk < n2) { e = x + 16; gb = b2 + blk; }
                else { blk -= n2; if (blk >= n3) return false; e = x + 24; gb = b3 + blk; } } }
        u.a = A + (size_t)gb * 256 * D;
        if (MODE == 1) u.b = B + ((size_t)e * 2 * DFF + (size_t)pn * 128) * D; else u.b = B + ((size_t)e * D + (size_t)pn * 256) * DFF;
        u.o = nullptr; u.i0 = (int)gb * 256; u.i1 = pn; u.i2 = e; u.i3 = 0; return true;
    }
};
__device__ __forceinline__ void p8_row(Frame& F, int t) {
    const int b = t >> 11; const float* mod = (const float*)(F.ws + WS_MOD);
    const int* tok_slot = (const int*)(F.ws + WS_ROUTE) + 3 * T * 4; const float* tok_w = (const float*)(F.ws + WS_ROUTE) + 2 * T * 4;
    const GAS f32x4* xr = (const GAS f32x4*)((const float*)(F.ws + WS_X2) + (size_t)t * D) + F.lane;
    f32x4 v[4], m[4];
#pragma unroll
    for (int j = 0; j < 4; ++j) { v[j] = xr[64 * j]; m[j] = (f32x4){0.f, 0.f, 0.f, 0.f}; }
#pragma unroll
    for (int k = 0; k < 4; ++k) { const int slot = tok_slot[t * 4 + k]; const float w = tok_w[t * 4 + k];
        const GAS v2u* yr = (const GAS v2u*)((const bf16*)(F.ws + WS_YS) + (size_t)slot * D) + F.lane;
#pragma unroll
        for (int j = 0; j < 4; ++j) { const v2u y = yr[64 * j]; m[j].x += w * bflo(y.x); m[j].y += w * bfhi(y.x); m[j].z += w * bflo(y.y); m[j].w += w * bfhi(y.y); } }
    float ss = 0.f;
#pragma unroll
    for (int j = 0; j < 4; ++j) { const f32x4 g = *(const f32x4*)(mod + b * 6144 + 5 * D + 4 * F.lane + 256 * j); v[j] = v[j] + g * m[j];
        ss += (v[j].x * v[j].x + v[j].y * v[j].y) + (v[j].z * v[j].z + v[j].w * v[j].w); }
    const float rinv = 1.0f / sqrtf(wave_sum(ss) * (1.0f / D) + NORM_EPS);
    GAS f32x4* orow = (GAS f32x4*)(F.out + (size_t)t * D) + F.lane;
#pragma unroll
    for (int j = 0; j < 4; ++j) { const f32x4 g = *(const f32x4*)(F.in[I_FG] + 4 * F.lane + 256 * j); orow[64 * j] = v[j] * rinv * g; }
}

constexpr int N_PHASES = 11;
struct Args { const float* in[20]; float* out; unsigned char* ws; int ph_lo, ph_hi, li, pad; };
__global__ void __launch_bounds__(NTHR, 2) fwd_kernel(Args args) {
    extern __shared__ __attribute__((aligned(16))) unsigned char lds[];
    Frame F;
    F.lds = (LAS unsigned char*)lds; F.MISC = (volatile LAS unsigned*)(F.lds + MISC_OFF);
    F.tid = threadIdx.x; F.lane = F.tid & 63; F.wave = __builtin_amdgcn_readfirstlane(F.tid >> 6);
    F.G = gridDim.x; F.bid = blockIdx.x;
#pragma unroll
    for (int i = 0; i < 20; ++i) F.in[i] = args.in[i];
    F.out = args.out; F.ws = args.ws; F.ctl = (gu32*)(args.ws + WS_CTL);
    for (int u = F.tid; u < (LDS_BYTES - LDSCTL_OFF) / 4; u += NTHR) ((LAS unsigned*)(F.lds + LDSCTL_OFF))[u] = 0u;
    __syncthreads();
    const int lo = args.ph_lo, hi = args.ph_hi;
    const bool multi = (hi - lo) > 1;
    XcdBarrier bar; bar.bar = (unsigned*)(F.ctl + CW_BAR) + args.li * XCD_BAR_WORDS; bar.x = 0; bar.st = nullptr;
    if (multi) bar = xcd_barrier_post((unsigned*)(F.ctl + CW_BAR) + args.li * XCD_BAR_WORDS, F.MISC + 8);
#define IN(k) (lo <= (k) && (k) < hi)
#define REPS(k) _Pragma("unroll") for (int _rep = 0; _rep < (((k) == PROBE_PHASE) ? PROBE_REPS : 1); ++_rep)
#define SEAM(k) do { if (IN(k) && IN((k) + 1)) xcd_barrier(bar); } while (0)
    const int gw = F.bid * NWAVES + F.wave, NGW = F.G * NWAVES;

    const int _pass = args.li;
    if (PROBE_PHASE == 102) { unsigned acc_ = 0; const size_t gt_ = (size_t)F.bid * NTHR + F.tid, ng_ = (size_t)F.G * NTHR;
        for (size_t pg = gt_; pg < WS_END / 4096; pg += ng_) acc_ += *(const volatile unsigned*)(F.ws + pg * 4096);
        const size_t insz[5] = {(size_t)T * D * 4, (size_t)NE * D * 2 * DFF * 4, (size_t)NE * DFF * D * 4, (size_t)D * 6 * D * 4, (size_t)D * 3072 * 4}; const float* inp[5] = {F.in[I_X], F.in[I_W1], F.in[I_W2], F.in[I_ADAW], F.in[I_WIN]};
        _Pragma("unroll") for (int q = 0; q < 5; ++q) for (size_t pg = gt_; pg < insz[q] / 4096; pg += ng_) acc_ += *(const volatile unsigned*)((const char*)inp[q] + pg * 4096);
        asm volatile("" :: "v"(acc_)); __syncthreads(); }
    if (PROBE_PHASE == 103) { unsigned long long pc_; asm volatile("s_getpc_b64 %0" : "=s"(pc_)); const char* cb_ = (const char*)(pc_ & ~0xFFull); unsigned acc_ = 0;
        for (int off = F.tid * 64; off < 96 * 1024; off += NTHR * 64) acc_ += *(const volatile unsigned*)(cb_ + off);
        asm volatile("" :: "v"(acc_)); }
    if (PROBE_PHASE == 105) { const unsigned long long t0 = __builtin_amdgcn_s_memrealtime(); f32x4 acc_ = (f32x4){0.f,0.f,0.f,0.f}; const f32x4* src_ = (const f32x4*)F.in[I_W1]; size_t idx_ = (size_t)F.bid * NTHR + F.tid; const size_t n4_ = (size_t)NE * D * 2 * DFF / 4;
        while (__builtin_amdgcn_s_memrealtime() - t0 < (unsigned long long)PROBE_REPS * 100ull) { _Pragma("unroll") for (int i = 0; i < 8; ++i) { acc_ += src_[idx_]; idx_ += (size_t)F.G * NTHR; if (idx_ >= n4_) idx_ -= n4_; } }
        asm volatile("" :: "v"(acc_)); __syncthreads(); }
    if (PROBE_PHASE == 107 && args.pad == 77) { f32x4 acc_ = (f32x4){0.f,0.f,0.f,0.f}; const size_t gt_ = (size_t)F.bid * NTHR + F.tid, ng_ = (size_t)F.G * NTHR;
        { const f32x4* src_ = (const f32x4*)F.in[I_W1]; const size_t n4_ = (size_t)NE * D * 2 * DFF / 4; for (size_t i = gt_; i < n4_; i += ng_) acc_ += src_[i]; }
        { const f32x4* src_ = (const f32x4*)F.in[I_W2]; const size_t n4_ = (size_t)NE * D * DFF / 4; for (size_t i = gt_; i < n4_; i += ng_) acc_ += src_[i]; }
        asm volatile("" :: "v"(acc_)); }
    if (PROBE_PHASE == 108 && args.pad == 78) { const size_t gt_ = (size_t)F.bid * NTHR + F.tid, ng_ = (size_t)F.G * NTHR; v4u* dst_ = (v4u*)(F.ws + WS_WB1); const size_t n_ = (size_t)192 * MiB / 16;
        for (size_t i = gt_; i < n_; i += ng_) dst_[i] = (v4u){0u, 0u, 0u, 0u}; }
    if (PROBE_PHASE == 109) { asm volatile(".rept 16384\n s_nop 0\n .endr" ::: "memory"); }
    if (PROBE_PHASE == 110) { const unsigned long long t0 = __builtin_amdgcn_s_memrealtime(); f32x4 ac_ = (f32x4){0.f,0.f,0.f,0.f}; bf16x8 aa_, bb_; for (int i = 0; i < 8; ++i) { aa_[i] = (short)(0x3f80 + F.lane); bb_[i] = (short)(0x3c00 + i); }
        while (__builtin_amdgcn_s_memrealtime() - t0 < (unsigned long long)PROBE_REPS * 100ull) { _Pragma("unroll") for (int i = 0; i < 32; ++i) ac_ = __builtin_amdgcn_mfma_f32_16x16x32_bf16(aa_, bb_, ac_, 0, 0, 0); }
        asm volatile("" :: "v"(ac_)); }
    if (PROBE_PHASE == 101) { const unsigned long long t0 = __builtin_amdgcn_s_memrealtime(); float xa = (float)F.tid, xb = 1.0001f; while (__builtin_amdgcn_s_memrealtime() - t0 < 20000ull) { _Pragma("unroll") for (int i = 0; i < 64; ++i) xa = fmaf(xa, xb, 0.5f); } asm volatile("" :: "v"(xa)); }
    if (IN(0)) REPS(0) { p0_prologue(F, args.pad ? args.pad : 3); }
    SEAM(0);
    if (IN(1)) REPS(1) { p1_phase(F); }
    SEAM(1);
    if (IN(2)) REPS(2) {
        SchedInproj S{F.G, F.bid, (const char*)(F.ws + WS_HMOD), (const char*)(F.ws + WS_WINT), (char*)(F.ws + WS_PX), (char*)(F.ws + WS_PT)};
        pg8::EpiStoreBf16 E;
        pg8::gemm_phase(F.lds, D * 2, (size_t)128 * D * 2, (size_t)128 * D * 2, S, E);
    }
    SEAM(2);
    if (IN(3)) {
        REPS(30) { for (int ch = F.bid; ch < 256; ch += F.G) p3_gla_chunked(F, ch); }
        REPS(31) {
        SchedFourier S{F.G, F.bid, (const char*)(F.ws + WS_DFT), (const char*)(F.ws + WS_PT), (char*)(F.ws + WS_EO)};
        pg8::EpiStoreBf16 E;
        pg8::gemm_phase(F.lds, SEQ * 2, (size_t)128 * SEQ * 2, (size_t)128 * SEQ * 2, S, E);
        }
    }
    SEAM(3);
    if (IN(4)) REPS(4) { for (int t = gw; t < T; t += NGW) p3c_row(F, t); }
    SEAM(4);
    if (IN(5)) REPS(5) {
        SchedWout S{F.G, F.bid, (const char*)(F.ws + WS_MIX), (const char*)(F.ws + WS_WOUT)};
        pg8::EpiWout E{F.in[I_X], (const float*)(F.ws + WS_POS), (const float*)(F.ws + WS_MOD), (float*)(F.ws + WS_X2)};
        pg8::gemm_phase(F.lds, D * 2, (size_t)128 * D * 2, (size_t)128 * D * 2, S, E);
    }
    SEAM(5);
    if (IN(6)) REPS(6) { __syncthreads(); p5a_phase(F, CW_CNT0 + 32 * (_rep + _pass)); }
    SEAM(6);
    if (IN(7)) REPS(7) { p5c_phase(F); }
    SEAM(7);
    if (IN(8)) REPS(8) {
        volatile LAS unsigned* boff = F.MISC + 16; moe_offsets(F, boff);
        SchedMoe<8, 1> S; S.init(F, boff, (const char*)(F.ws + WS_HMP), (const char*)(F.ws + WS_WB1));
        pg8::EpiMoe1 E{F.in[I_B1], F.ws + WS_HH};
        pg8::gemm_phase<pg8::EpiMoe1, SchedMoe<8, 1>, true>(F.lds, D, (size_t)128 * D, (size_t)DFF * D, S, E);
    }
    SEAM(8);
    if (IN(9)) REPS(9) {
        volatile LAS unsigned* boff = F.MISC + 16; moe_offsets(F, boff);
        SchedMoe<4, 2> S; S.init(F, boff, (const char*)(F.ws + WS_HH), (const char*)(F.ws + WS_WB2));
        pg8::EpiMoe2 E{F.in[I_B2], (bf16*)(F.ws + WS_YS)};
        pg8::gemm_phase<pg8::EpiMoe2, SchedMoe<4, 2>, true>(F.lds, DFF, (size_t)128 * DFF, (size_t)128 * DFF, S, E);
    }
    SEAM(9);
    if (IN(10)) REPS(10) { for (int t = gw; t < T; t += NGW) p8_row(F, t); }
#undef IN
#undef SEAM
}

__global__ void zero_ctl_kernel(unsigned* p, int n) { const int i = blockIdx.x * blockDim.x + threadIdx.x; if (i < n) p[i] = 0u; }
extern "C" void kernel_launch(void* const* d_in, const int* in_sizes, int n_in, void* d_out, int out_size, void* d_ws, size_t ws_size, hipStream_t stream) {
    static int grid = 0;
    if (grid == 0) {
        if (n_in != 20 || out_size != T * D || ws_size < WS_END) { fprintf(stderr, "kernel_launch: unexpected shapes (n_in %d out %d ws %zu need %zu)\n", n_in, out_size, ws_size, (size_t)WS_END); grid = -1; return; }
        int dev = 0, cus = 0, per_cu = 0;
        if (hipGetDevice(&dev) != hipSuccess || hipDeviceGetAttribute(&cus, hipDeviceAttributeMultiprocessorCount, dev) != hipSuccess) { grid = -1; return; }
        if (hipFuncSetAttribute((const void*)fwd_kernel, hipFuncAttributeMaxDynamicSharedMemorySize, LDS_BYTES) != hipSuccess) { fprintf(stderr, "kernel_launch: hipFuncSetAttribute failed\n"); grid = -1; return; }
        if (hipOccupancyMaxActiveBlocksPerMultiprocessor(&per_cu, (const void*)fwd_kernel, NTHR, LDS_BYTES) != hipSuccess || per_cu < 1) { fprintf(stderr, "kernel_launch: occupancy query says %d\n", per_cu); }
        (void)hipGetLastError();
        grid = cus;
    }
    if (grid < 0) return;
    if (PROBE_PHASE == 111) { hipLaunchKernelGGL(zero_ctl_kernel, dim3(CTL_ZERO_BYTES / 4 / 256), dim3(256), 0, stream, (unsigned*)d_ws, (int)(CTL_ZERO_BYTES / 4)); }
    else if (hipMemsetAsync((char*)d_ws + WS_CTL, 0, CTL_ZERO_BYTES, stream) != hipSuccess) return;
    Args a{};
    for (int i = 0; i < 20; ++i) a.in[i] = (const float*)d_in[i];
    a.out = (float*)d_out; a.ws = (unsigned char*)d_ws;
#if MK_N_LAUNCHES == 1
    a.ph_lo = 0; a.ph_hi = N_PHASES;
    for (int li = 0; li < NPASS; ++li) { a.li = li; if (PROBE_PHASE == 104) { a.ph_lo = (li == 0) ? PROBE_REPS - 1 : 0; a.ph_hi = (li == 0) ? PROBE_REPS : N_PHASES; }
        if (PROBE_PHASE == 107) { a.ph_lo = 0; a.ph_hi = (li == 0) ? 0 : N_PHASES; a.pad = (li == 0) ? 77 : 0; }
        if (PROBE_PHASE == 108) { a.ph_lo = 0; a.ph_hi = (li == 0) ? 0 : N_PHASES; a.pad = (li == 0) ? 78 : 0; }
        if (PROBE_PHASE == 106) { a.ph_lo = 0; a.ph_hi = (li == 0) ? 1 : N_PHASES; a.pad = (li == 0) ? PROBE_REPS : 0; } hipLaunchKernelGGL(fwd_kernel, dim3(grid), dim3(NTHR), LDS_BYTES, stream, a); }
#else
    for (int p = 0; p < N_PHASES; ++p) { a.ph_lo = p; a.ph_hi = p + 1; hipLaunchKernelGGL(fwd_kernel, dim3(grid), dim3(NTHR), LDS_BYTES, stream, a); }
#endif
}
```

```cpp
#include <hip/hip_runtime.h>
#include <cstdio>
#include <cstdint>

#ifndef PROBE_PHASE
#define PROBE_PHASE (-1)
#define PROBE_REPS 2
#endif
#ifndef MK_N_LAUNCHES
#define MK_N_LAUNCHES 1
#endif

#define GAS __attribute__((address_space(1)))
#define LAS __attribute__((address_space(3)))
typedef unsigned short bf16;
typedef unsigned v4u __attribute__((ext_vector_type(4)));
typedef unsigned v2u __attribute__((ext_vector_type(2)));
typedef float f32x4 __attribute__((ext_vector_type(4)));
typedef float f32x2 __attribute__((ext_vector_type(2)));
typedef short bf16x8 __attribute__((ext_vector_type(8)));
typedef GAS unsigned gu32;

constexpr int D = 1024, NB = 8, SEQ = 2048, T = NB * SEQ, CTX = 256, TC = NB * CTX, TA = T + TC;
constexpr int HW = 512, HD = 128, NH = 4, FWID = 512, NG = 4, GD = 128;
constexpr int NPX = 5 * HW;
constexpr int NE = 32, TOPK = 4, DFF = 1024;
constexpr int SLOT_MAX = T * TOPK + NE * 256;
constexpr float NORM_EPS = 1e-6f;
constexpr int NWAVES = 8, NTHR = 512;

constexpr size_t MiB = 1u << 20;
constexpr size_t WS_CTL = 0, CTL_ZERO_BYTES = 1 * MiB;
constexpr size_t WS_MOD = 1 * MiB;
constexpr size_t WS_LB = WS_MOD + 9 * 6144 * 4;
constexpr size_t WS_ROUTE = WS_LB + 4096;
constexpr size_t WS_MG = 3 * MiB;
constexpr size_t WS_POS = 4 * MiB;
constexpr size_t WS_WINT = 12 * MiB;
constexpr size_t WS_WOUT = 19 * MiB;
constexpr size_t WS_DFT = 21 * MiB;
constexpr size_t WS_WB1 = 37 * MiB;
constexpr size_t WS_WB2 = 165 * MiB;
constexpr size_t WS_HMOD = 229 * MiB;
constexpr size_t WS_R1 = 265 * MiB;
constexpr size_t WS_PX = WS_R1;
constexpr size_t WS_PT = WS_PX + 90 * MiB;
constexpr size_t WS_OGLA = WS_PT + 32 * MiB;
constexpr size_t WS_EO = WS_OGLA + 64 * MiB;
constexpr size_t WS_HMP = WS_R1;
constexpr size_t WS_YS = WS_R1 + 72 * MiB;
constexpr size_t WS_MIX = WS_R1 + 218 * MiB;
constexpr size_t WS_X2 = WS_MIX + 32 * MiB;
constexpr size_t WS_HM = WS_X2 + 64 * MiB;
constexpr size_t WS_HH = WS_HM + 32 * MiB;
constexpr size_t WS_END = WS_HH + 144 * MiB;
static_assert(WS_END <= 1024 * MiB && WS_YS + 144 * MiB <= WS_MIX, "workspace map");
constexpr float SC_W = 64.0f, SC_HM = 16.0f, SC_HH = 4.0f;
constexpr int CW_CNT0 = 64;
#define NPASS ((PROBE_PHASE == 100 || PROBE_PHASE == 104 || PROBE_PHASE == 106 || PROBE_PHASE == 107 || PROBE_PHASE == 108) ? 2 : 1)
#define CW_CNT (CW_CNT0 + ((PROBE_PHASE == 6) ? 32 * (PROBE_REPS - 1) : 0) + ((PROBE_PHASE == 100 || PROBE_PHASE == 104 || PROBE_PHASE == 106 || PROBE_PHASE == 107 || PROBE_PHASE == 108) ? 32 : 0))
constexpr int CW_BAR = 4096;

constexpr int RING_BYTES = 131072;
constexpr int LDSCTL_OFF = RING_BYTES, MISC_OFF = LDSCTL_OFF + 320;
constexpr int LDS_BYTES = 147456;

#define LDS_WAIT() asm volatile("s_waitcnt lgkmcnt(0)" ::: "memory")
#define VM_WAIT() asm volatile("s_waitcnt vmcnt(0)" ::: "memory")
__device__ __forceinline__ unsigned f2bf(float f) { unsigned u = __builtin_bit_cast(unsigned, f); return (u + 0x7fffu + ((u >> 16) & 1u)) >> 16; }
__device__ __forceinline__ unsigned pk2(float lo, float hi) { return f2bf(lo) | (f2bf(hi) << 16); }
__device__ __forceinline__ float bf2f(unsigned short b) { return __builtin_bit_cast(float, ((unsigned)b) << 16); }
__device__ __forceinline__ float bflo(unsigned u) { return __builtin_bit_cast(float, u << 16); }
__device__ __forceinline__ float bfhi(unsigned u) { return __builtin_bit_cast(float, u & 0xffff0000u); }
__device__ __forceinline__ unsigned pk4_fp8(float a, float b, float c, float d) {
    a = __builtin_amdgcn_fmed3f(a, -448.f, 448.f); b = __builtin_amdgcn_fmed3f(b, -448.f, 448.f); c = __builtin_amdgcn_fmed3f(c, -448.f, 448.f); d = __builtin_amdgcn_fmed3f(d, -448.f, 448.f);
    int p = 0; p = __builtin_amdgcn_cvt_pk_fp8_f32(a, b, p, false); p = __builtin_amdgcn_cvt_pk_fp8_f32(c, d, p, true); return (unsigned)p; }
__device__ __forceinline__ float sigmoidf_(float x) { return __builtin_amdgcn_rcpf(1.0f + __expf(-x)); }

#define XB_TMO      128
#define XB_XCNT(j)  (256  + 64 * (j))
#define XB_XSUB(j)  (1280 + 64 * (j))
#define XB_XGEN(j)  (2304 + 64 * (j))
#define XB_TOP      3328
#define XB_TOPGEN   3392
#define XCD_BAR_WORDS 3456
#define XB_SPIN_CAP (1u << 18)
__device__ __forceinline__ unsigned xb_ld(unsigned* p)              { return __hip_atomic_load(p, __ATOMIC_RELAXED, __HIP_MEMORY_SCOPE_AGENT); }
__device__ __forceinline__ unsigned xb_add(unsigned* p, unsigned v) { return __hip_atomic_fetch_add(p, v, __ATOMIC_RELAXED, __HIP_MEMORY_SCOPE_AGENT); }
__device__ __forceinline__ unsigned xb_xcc_id() { return (unsigned)__builtin_amdgcn_s_getreg((3 << 11) | 20) & 0xFu; }
#define XB_SPIN(cond, bar) do { unsigned _sp = 0; while (cond) { __builtin_amdgcn_s_sleep(1); \
    if ((++_sp & 255u) == 0u) { if (xb_ld(&(bar)[XB_TMO])) break; if (_sp > XB_SPIN_CAP) { atomicAdd(&(bar)[XB_TMO], 1u); break; } } } } while (0)
struct XcdBarrier { unsigned* bar; unsigned x; volatile LAS unsigned* st; };
__device__ __forceinline__ XcdBarrier xcd_barrier_post(unsigned* bar, volatile LAS unsigned* st) {
    XcdBarrier b; b.bar = bar; b.x = xb_xcc_id(); b.st = st;
    if (threadIdx.x == 0) (void)xb_add(&bar[XB_XCNT(b.x)], 1u);
    return b;
}
__device__ __forceinline__ void xcd_barrier_complete(unsigned* bar, unsigned x, unsigned& nloc, unsigned& nx) {
    const unsigned G = gridDim.x * gridDim.y * gridDim.z;
    unsigned sum, cnt, mine, sp = 0u;
    for (;;) {
        sum = 0u; cnt = 0u; mine = 0u;
#pragma unroll
        for (unsigned j = 0; j < 16; ++j) { const unsigned c = xb_ld(&bar[XB_XCNT(j)]); sum += c; cnt += (c > 0u) ? 1u : 0u; mine = (j == x) ? c : mine; }
        if (sum == G) break;
        __builtin_amdgcn_s_sleep(1);
        if ((++sp & 255u) == 0u) { if (xb_ld(&bar[XB_TMO])) break; if (sp > XB_SPIN_CAP) { atomicAdd(&bar[XB_TMO], 1u); break; } }
    }
    nloc = mine > 0u ? mine : 1u; nx = cnt > 0u ? cnt : 1u;
}
__device__ __forceinline__ void xcd_barrier(const XcdBarrier& b) {
    asm volatile("s_waitcnt vmcnt(0)" ::: "memory");
    __syncthreads();
    if (threadIdx.x == 0) {
        unsigned* bar = b.bar;
        __builtin_amdgcn_s_waitcnt(0);
        unsigned nloc = b.st[0], nx = b.st[1];
        if (nloc == 0u) { xcd_barrier_complete(bar, b.x, nloc, nx); b.st[0] = nloc; b.st[1] = nx; }
        const unsigned old = xb_add(&bar[XB_XSUB(b.x)], 1u);
        const unsigned gen = old / nloc;
        if (old + 1u == (gen + 1u) * nloc) {
            __builtin_amdgcn_fence(__ATOMIC_RELEASE, "agent");
            asm volatile("s_waitcnt vmcnt(0)" ::: "memory");
            const unsigned og = xb_add(&bar[XB_TOP], 1u);
            const unsigned tg = og / nx;
            if (og + 1u == (tg + 1u) * nx) xb_add(&bar[XB_TOPGEN], 1u);
            else XB_SPIN(xb_ld(&bar[XB_TOPGEN]) == tg, bar);
            __builtin_amdgcn_fence(__ATOMIC_ACQUIRE, "agent");
            xb_add(&bar[XB_XGEN(b.x)], 1u);
            asm volatile("s_waitcnt vmcnt(0)" ::: "memory");
        } else {
            XB_SPIN(xb_ld(&bar[XB_XGEN(b.x)]) == gen, bar);
            __builtin_amdgcn_fence(__ATOMIC_ACQUIRE, "agent");
            asm volatile("s_waitcnt vmcnt(0)" ::: "memory");
        }
    }
    __syncthreads();
}

namespace pg8 {
constexpr int BM = 256, BK = 64, HALF = 128, HTB = HALF * BK * 2, NXCD = 8, WGM = 8;
__host__ __device__ __forceinline__ int lds_byte(int r, int c) { const int st = (r >> 4) * 2 + (c >> 5), rr = r & 15, cc = c & 31, ob = rr * 64 + cc * 2; return st * 1024 + (ob ^ (((ob >> 9) & 1) << 5)); }
__host__ __device__ __forceinline__ void stage_rc(int b, int& R, int& C) { const int st = b / 1024, sb = b % 1024, swz = sb ^ (((sb >> 9) & 1) << 5); R = (st >> 1) * 16 + swz / 64; C = (st & 1) * 32 + (swz % 64) / 2; }
__host__ __device__ __forceinline__ int perm32(int rho) { const int n = rho >> 4, i = rho & 15; return 8 * (i >> 2) + 4 * n + (i & 3); }

struct Unit { const char* a; const char* b; char* o; int i0, i1, i2, i3; };

__device__ __forceinline__ void tile_of(int L, int nM, int nN, int& pm, int& pn) {
    const int nwg = nM * nN; int wgid = L;
    { const int q = nwg / NXCD, r = nwg % NXCD, xcd = wgid % NXCD, off = wgid / NXCD; wgid = (xcd < r ? xcd * (q + 1) : r * (q + 1) + (xcd - r) * q) + off; }
    const int nig = WGM * nN, gid = wgid / nig, fm = gid * WGM, gsz = (nM - fm) < WGM ? (nM - fm) : WGM;
    pm = fm + ((wgid % nig) % gsz); pn = (wgid % nig) / gsz;
}
__device__ __forceinline__ unsigned cvt_pk_bf16(float lo, float hi) { unsigned r; asm volatile("v_cvt_pk_bf16_f32 %0, %1, %2" : "=v"(r) : "v"(lo), "v"(hi)); return r; }

typedef int v8i_t __attribute__((ext_vector_type(8)));
typedef int v4i_t __attribute__((ext_vector_type(4)));
template <class Epi, class Sched, bool FP8 = false>
__device__ __forceinline__ void gemm_phase(LAS unsigned char* lds, const int rowbytes, const size_t hsA, const size_t hsB, const Sched& S, const Epi& E) {
    const int tid = threadIdx.x, wid = __builtin_amdgcn_readfirstlane(tid >> 6), lane = tid & 63, wr = wid >> 2, wc = wid & 3, fr = lane & 15, fq = lane >> 4;
    const int nt = rowbytes / 128;
    unsigned voffA[2], voffB[2];
#pragma unroll
    for (int i = 0; i < 2; ++i) { int R, C; stage_rc(tid * 16 + i * 8192, R, C); const int Rb = Epi::PERM ? ((R & ~31) + perm32(R & 31)) : R;
        voffA[i] = (unsigned)(R * rowbytes + C * 2); voffB[i] = (unsigned)(Rb * rowbytes + C * 2); }
    const size_t kstep = (size_t)(BK * 2);
    const unsigned ldsw = (unsigned)wid * 1024u;
    const int aoff = lds_byte(wr * 64 + fr, fq * 8), boff = lds_byte(wc * 32 + fr, fq * 8);
#define PG8_SA(b, h) (((b) * 2 + (h)) * HTB)
#define PG8_SB(b, h) ((4 + (b) * 2 + (h)) * HTB)
#define PG8_STAGE(bufoff, gbase, voff) do { _Pragma("unroll") for (int _i = 0; _i < 2; ++_i) \
        __builtin_amdgcn_global_load_lds((const unsigned*)((const char*)(gbase) + (voff)[_i]), (LAS unsigned*)(lds + (bufoff) + ldsw + _i * 8192), 16, 0, 0); } while (0)
#define PG8_LD2(p) __builtin_shufflevector(*(const LAS v4i_t*)(p), *(const LAS v4i_t*)((p) + 1024), 0, 1, 2, 3, 4, 5, 6, 7)
#define PG8_LDA(dst, b, h) do { _Pragma("unroll") for (int m = 0; m < 4; ++m) dst[m] = PG8_LD2(lds + PG8_SA(b, h) + aoff + m * 2048); } while (0)
#define PG8_LDB(dst, b, h) do { _Pragma("unroll") for (int n = 0; n < 2; ++n) dst[n] = PG8_LD2(lds + PG8_SB(b, h) + boff + n * 2048); } while (0)
#define PG8_LO(x) __builtin_bit_cast(bf16x8, __builtin_shufflevector((x), (x), 0, 1, 2, 3))
#define PG8_HI(x) __builtin_bit_cast(bf16x8, __builtin_shufflevector((x), (x), 4, 5, 6, 7))
#define PG8_MMA(ai, bj, At, Bt) do { if constexpr (FP8) __builtin_amdgcn_sched_barrier(0); __builtin_amdgcn_s_setprio(1); _Pragma("unroll") for (int m = 0; m < 4; ++m) _Pragma("unroll") for (int n = 0; n < 2; ++n) { \
        if constexpr (FP8) { asm volatile("s_nop 1\n\tv_mfma_scale_f32_16x16x128_f8f6f4 %0, %1, %2, %0, %3, %3 op_sel_hi:[0,0,0]" : "+v"(acc[ai][bj][m][n]) : "v"(Bt[n]), "v"(At[m]), "v"(sc1)); } \
        else { acc[ai][bj][m][n] = __builtin_amdgcn_mfma_f32_16x16x32_bf16(PG8_LO(Bt[n]), PG8_LO(At[m]), acc[ai][bj][m][n], 0, 0, 0); \
               acc[ai][bj][m][n] = __builtin_amdgcn_mfma_f32_16x16x32_bf16(PG8_HI(Bt[n]), PG8_HI(At[m]), acc[ai][bj][m][n], 0, 0, 0); } } __builtin_amdgcn_s_setprio(0); if constexpr (FP8) __builtin_amdgcn_sched_barrier(0); } while (0)
#define PG8_WAIT_V(n) asm volatile("s_waitcnt vmcnt(" #n ")" ::: "memory")
#define PG8_WAIT_L(n) asm volatile("s_waitcnt lgkmcnt(" #n ")" ::: "memory")
#define PG8_BAR __builtin_amdgcn_s_barrier()
#define PG8_SCHED __builtin_amdgcn_sched_barrier(0)
    Unit cur, nxt; int ui = 0;
    if (!S.next(0, cur)) return;
    f32x4 acc[2][2][4][2];
#pragma unroll
    for (int a = 0; a < 2; ++a)
#pragma unroll
        for (int b = 0; b < 2; ++b)
#pragma unroll
            for (int m = 0; m < 4; ++m)
#pragma unroll
                for (int n = 0; n < 2; ++n) acc[a][b][m][n] = (f32x4){0.f, 0.f, 0.f, 0.f};
    v8i_t At[4], B0[2], B1[2];
    int sc1 = 0x7f7f7f7f; asm volatile("" : "+v"(sc1));
    const char* cA = cur.a; const char* cB = cur.b;
    PG8_STAGE(PG8_SB(0, 0), cB, voffB); PG8_STAGE(PG8_SB(0, 1), cB + hsB, voffB); PG8_STAGE(PG8_SA(0, 0), cA, voffA); PG8_STAGE(PG8_SA(0, 1), cA + hsA, voffA);
    if (wr == 1) PG8_BAR;
    PG8_WAIT_V(2); PG8_BAR;
    PG8_STAGE(PG8_SB(1, 0), cB + kstep, voffB); PG8_STAGE(PG8_SA(1, 0), cA + kstep, voffA); PG8_STAGE(PG8_SB(1, 1), cB + hsB + kstep, voffB);
    PG8_WAIT_V(6); PG8_BAR;
    for (;;) {
        const bool has_next = S.next(ui + 1, nxt);
        const char* nA = has_next ? nxt.a : cA; const char* nB = has_next ? nxt.b : cB;
#pragma nounroll
        for (int t = 0; t < nt; t += 2) {
            const bool last = (t == nt - 2);
            const char* a1 = cA + (size_t)(t + 1) * kstep;
            const char* a2 = last ? nA : cA + (size_t)(t + 2) * kstep; const char* b2 = last ? nB : cB + (size_t)(t + 2) * kstep;
            const char* a3 = a2 + kstep; const char* b3 = b2 + kstep;
            PG8_LDB(B0, 0, 0); PG8_LDB(B1, 0, 1); PG8_SCHED; PG8_LDA(At, 0, 0); PG8_STAGE(PG8_SA(1, 1), a1 + hsA, voffA);
            PG8_WAIT_V(8); PG8_WAIT_L(0); PG8_BAR; PG8_MMA(0, 0, At, B0); PG8_MMA(0, 1, At, B1); PG8_BAR; PG8_SCHED;
            PG8_LDA(At, 0, 1); PG8_STAGE(PG8_SB(0, 0), b2, voffB); PG8_STAGE(PG8_SB(0, 1), b2 + hsB, voffB); PG8_STAGE(PG8_SA(0, 0), a2, voffA);
            PG8_WAIT_V(8); PG8_WAIT_L(0); PG8_BAR; PG8_MMA(1, 0, At, B0); PG8_MMA(1, 1, At, B1); PG8_BAR; PG8_SCHED;
            PG8_LDB(B0, 1, 0); PG8_LDB(B1, 1, 1); PG8_SCHED; PG8_LDA(At, 1, 0); PG8_STAGE(PG8_SA(0, 1), a2 + hsA, voffA);
            PG8_WAIT_V(8); PG8_WAIT_L(0); PG8_BAR; PG8_MMA(0, 0, At, B0); PG8_MMA(0, 1, At, B1); PG8_BAR; PG8_SCHED;
            PG8_LDA(At, 1, 1); PG8_STAGE(PG8_SB(1, 0), b3, voffB); PG8_STAGE(PG8_SB(1, 1), b3 + hsB, voffB); PG8_STAGE(PG8_SA(1, 0), a3, voffA);
            PG8_WAIT_V(8); PG8_WAIT_L(0); PG8_BAR; PG8_MMA(1, 0, At, B0); PG8_MMA(1, 1, At, B1); PG8_BAR; PG8_SCHED;
        }
        if constexpr (FP8) asm volatile("s_nop 15\n\ts_nop 15" ::: "memory");
        if (wr == 0) PG8_BAR;
        E(acc, cur, wr, wc, fr, fq);
        if (!has_next) break;
#pragma unroll
        for (int a = 0; a < 2; ++a)
#pragma unroll
            for (int b = 0; b < 2; ++b)
#pragma unroll
                for (int m = 0; m < 4; ++m)
#pragma unroll
                    for (int n = 0; n < 2; ++n) acc[a][b][m][n] = (f32x4){0.f, 0.f, 0.f, 0.f};
        cur = nxt; cA = nA; cB = nB; ++ui;
        if (wr == 1) PG8_BAR;
    }
    PG8_WAIT_V(0);
    PG8_BAR;
#undef PG8_SA
#undef PG8_SB
#undef PG8_STAGE
#undef PG8_LDA
#undef PG8_LDB
#undef PG8_MMA
#undef PG8_LO
#undef PG8_HI
#undef PG8_LD2
#undef PG8_WAIT_V
#undef PG8_WAIT_L
#undef PG8_BAR
#undef PG8_SCHED
}

struct EpiStoreBf16 {
    static constexpr bool PERM = true;
    __device__ __forceinline__ void operator()(const f32x4 (&acc)[2][2][4][2], const Unit& u, int wr, int wc, int fr, int fq) const {
        bf16* base = (bf16*)u.o; const size_t ld = (size_t)u.i0;
        const int row0 = wr * 64 + fr, col0 = wc * 32 + 8 * fq;
#pragma unroll
        for (int ai = 0; ai < 2; ++ai)
#pragma unroll
            for (int m = 0; m < 4; ++m) { bf16* rowp = base + (size_t)(row0 + ai * HALF + m * 16) * ld + col0;
#pragma unroll
                for (int bj = 0; bj < 2; ++bj) { const f32x4 v0 = acc[ai][bj][m][0], v1 = acc[ai][bj][m][1];
                    v4u w; w.x = cvt_pk_bf16(v0[0], v0[1]); w.y = cvt_pk_bf16(v0[2], v0[3]); w.z = cvt_pk_bf16(v1[0], v1[1]); w.w = cvt_pk_bf16(v1[2], v1[3]);
                    *(v4u*)(rowp + bj * HALF) = w; } }
    }
};
struct EpiWout {
    static constexpr bool PERM = false;
    const float* x; const float* pos; const float* mod; float* x2;
    __device__ __forceinline__ void operator()(const f32x4 (&acc)[2][2][4][2], const Unit& u, int wr, int wc, int fr, int fq) const {
        const int row0 = u.i0 + wr * 64 + fr, col0 = u.i1 + wc * 32 + 4 * fq; const int b = u.i0 >> 11;
        f32x4 gv[2][2];
#pragma unroll
        for (int bj = 0; bj < 2; ++bj)
#pragma unroll
            for (int n = 0; n < 2; ++n) gv[bj][n] = *(const f32x4*)(mod + b * 6144 + 2 * D + col0 + bj * HALF + n * 16);
#pragma unroll
        for (int ai = 0; ai < 2; ++ai)
#pragma unroll
            for (int m = 0; m < 4; ++m) { const int t = row0 + ai * HALF + m * 16; const size_t ro = (size_t)t * D + col0; const size_t po = (size_t)(t & (SEQ - 1)) * D + col0;
#pragma unroll
                for (int bj = 0; bj < 2; ++bj)
#pragma unroll
                    for (int n = 0; n < 2; ++n) { const int co = bj * HALF + n * 16;
                        const f32x4 xv = *(const f32x4*)(x + ro + co), pv = *(const f32x4*)(pos + po + co);
                        *(f32x4*)(x2 + ro + co) = xv + pv + gv[bj][n] * acc[ai][bj][m][n]; } }
    }
};
struct EpiMoe1 {
    static constexpr bool PERM = true;
    const float* b1; unsigned char* hh;
    __device__ __forceinline__ void operator()(const f32x4 (&acc)[2][2][4][2], const Unit& u, int wr, int wc, int fr, int fq) const {
        const int row0 = u.i0 + wr * 64 + fr, col0 = u.i1 * HALF + wc * 32 + 8 * fq;
        const float* bb = b1 + (size_t)u.i2 * (2 * DFF) + col0;
        constexpr float inv = 1.0f / (SC_W * SC_HM);
        f32x4 bg[2], bl[2];
#pragma unroll
        for (int n = 0; n < 2; ++n) { bg[n] = *(const f32x4*)(bb + 4 * n); bl[n] = *(const f32x4*)(bb + DFF + 4 * n); }
#pragma unroll
        for (int ai = 0; ai < 2; ++ai)
#pragma unroll
            for (int m = 0; m < 4; ++m) { unsigned char* rowp = hh + (size_t)(row0 + ai * HALF + m * 16) * DFF + col0;
                float r[8];
#pragma unroll
                for (int n = 0; n < 2; ++n) { const f32x4 g = acc[ai][0][m][n] * inv + bg[n], l = acc[ai][1][m][n] * inv + bl[n];
#pragma unroll
                    for (int j = 0; j < 4; ++j) { const float ag = fminf(g[j], 7.0f), al = fminf(fmaxf(l[j], -7.0f), 7.0f);
                        r[4 * n + j] = SC_HH * ag * sigmoidf_(1.702f * ag) * (al + 1.0f); } }
                v2u w; w.x = pk4_fp8(r[0], r[1], r[2], r[3]); w.y = pk4_fp8(r[4], r[5], r[6], r[7]);
                *(v2u*)rowp = w; }
    }
};
struct EpiMoe2 {
    static constexpr bool PERM = true;
    const float* b2; bf16* ys;
    __device__ __forceinline__ void operator()(const f32x4 (&acc)[2][2][4][2], const Unit& u, int wr, int wc, int fr, int fq) const {
        const int row0 = u.i0 + wr * 64 + fr, col0 = u.i1 * BM + wc * 32 + 8 * fq;
        const float* bb = b2 + (size_t)u.i2 * D + col0;
        constexpr float inv = 1.0f / (SC_W * SC_HH);
        f32x4 bv[2][2];
#pragma unroll
        for (int bj = 0; bj < 2; ++bj)
#pragma unroll
            for (int n = 0; n < 2; ++n) bv[bj][n] = *(const f32x4*)(bb + bj * HALF + 4 * n);
#pragma unroll
        for (int ai = 0; ai < 2; ++ai)
#pragma unroll
            for (int m = 0; m < 4; ++m) { bf16* rowp = ys + (size_t)(row0 + ai * HALF + m * 16) * D + col0;
#pragma unroll
                for (int bj = 0; bj < 2; ++bj) { const f32x4 v0 = acc[ai][bj][m][0] * inv + bv[bj][0], v1 = acc[ai][bj][m][1] * inv + bv[bj][1];
                    v4u w; w.x = cvt_pk_bf16(v0[0], v0[1]); w.y = cvt_pk_bf16(v0[2], v0[3]); w.z = cvt_pk_bf16(v1[0], v1[1]); w.w = cvt_pk_bf16(v1[2], v1[3]);
                    *(v4u*)(rowp + bj * HALF) = w; } }
    }
};
}

struct Frame {
    LAS unsigned char* lds; volatile LAS unsigned* MISC; gu32* ctl;
    int tid, lane, wave, G, bid;
    const float* in[20]; float* out; unsigned char* ws;
};
enum { I_X = 0, I_C, I_CTX, I_CCTX, I_ADAW, I_ADAB, I_N1G, I_WIN, I_LB, I_GN, I_FNW, I_WOUT, I_N2G, I_RW, I_RB, I_W1, I_B1, I_W2, I_B2, I_FG };

__device__ __forceinline__ float wave_sum(float v) {
#pragma unroll
    for (int o = 1; o < 64; o <<= 1) v += __shfl_xor(v, o);
    return v;
}
__device__ __forceinline__ float wave_max(float v) {
#pragma unroll
    for (int o = 1; o < 64; o <<= 1) v = fmaxf(v, __shfl_xor(v, o));
    return v;
}

__device__ __forceinline__ void p0_transpose_item(const float* W, int ldw, int K, int nblk, bf16* WT, LAS float* scr, int item, int lane) {
    const int kb = item / nblk, nb = item % nblk, k0 = 64 * kb, n0 = 32 * nb;
#pragma unroll 8
    for (int i = 0; i < 32; ++i) { const int kk = 2 * i + (lane >> 5); scr[kk * 33 + (lane & 31)] = W[(size_t)(k0 + kk) * ldw + n0 + (lane & 31)]; }
    LDS_WAIT(); asm volatile("" ::: "memory");
    const int c = lane & 7;
#pragma unroll
    for (int j = 0; j < 4; ++j) { const int n = (lane >> 3) + 8 * j; const LAS float* s = scr + (8 * c) * 33 + n;
        v4u o; o.x = pk2(s[0 * 33], s[1 * 33]); o.y = pk2(s[2 * 33], s[3 * 33]); o.z = pk2(s[4 * 33], s[5 * 33]); o.w = pk2(s[6 * 33], s[7 * 33]);
        *(GAS v4u*)(WT + (size_t)(n0 + n) * K + k0 + 8 * c) = o; }
    LDS_WAIT(); asm volatile("" ::: "memory");
}
struct Fp8Item { const float* src; unsigned char* dst; int ldw; };
__device__ __forceinline__ Fp8Item p0_fp8_item(Frame& F, int it, int lane) {
    Fp8Item r;
    if (it < NE * 1024) { const int e = it >> 10, q = it & 1023, kb = q >> 6, nb = q & 63; r.ldw = 2 * DFF;
        r.src = F.in[I_W1] + (size_t)e * D * 2 * DFF + (size_t)(64 * kb) * (2 * DFF) + 32 * nb; r.dst = F.ws + WS_WB1 + (size_t)e * 2 * DFF * D + (size_t)(32 * nb) * D + 64 * kb; }
    else { const int i2 = it - NE * 1024, e = i2 >> 9, q = i2 & 511, kb = q >> 5, nb = q & 31; r.ldw = D;
        r.src = F.in[I_W2] + (size_t)e * DFF * D + (size_t)(64 * kb) * D + 32 * nb; r.dst = F.ws + WS_WB2 + (size_t)e * D * DFF + (size_t)(32 * nb) * DFF + 64 * kb; }
    r.src += (size_t)(lane >> 3) * r.ldw + 4 * (lane & 7);
    return r;
}
__device__ __forceinline__ void p0_fp8_items(Frame& F, LAS float* scr, int first, int stride, int nitems) {
    const int lane = F.lane;
    f32x4 cur[8], nxt[8];
    int it = first; if (it >= nitems) return;
    Fp8Item ci = p0_fp8_item(F, it, lane);
#pragma unroll
    for (int i = 0; i < 8; ++i) cur[i] = *(const GAS f32x4*)(ci.src + (size_t)(8 * i) * ci.ldw);
    for (; it < nitems; it += stride) {
        const int itn = it + stride; const bool hn = itn < nitems;
        Fp8Item ni = ci;
        if (hn) { ni = p0_fp8_item(F, itn, lane);
#pragma unroll
            for (int i = 0; i < 8; ++i) nxt[i] = *(const GAS f32x4*)(ni.src + (size_t)(8 * i) * ni.ldw); }
#pragma unroll
        for (int i = 0; i < 8; ++i) *(LAS f32x4*)(scr + (8 * i + (lane >> 3)) * 36 + 4 * (lane & 7)) = cur[i];
        LDS_WAIT(); asm volatile("" ::: "memory");
        { const int n = lane & 31, hk = (lane >> 5) * 32; const LAS float* sp = scr + hk * 36 + n;
          unsigned o[8];
#pragma unroll
          for (int q = 0; q < 8; ++q) o[q] = pk4_fp8(SC_W * sp[(4 * q) * 36], SC_W * sp[(4 * q + 1) * 36], SC_W * sp[(4 * q + 2) * 36], SC_W * sp[(4 * q + 3) * 36]);
          GAS v4u* dst = (GAS v4u*)(ci.dst + (size_t)n * D + hk);
          dst[0] = (v4u){o[0], o[1], o[2], o[3]}; dst[1] = (v4u){o[4], o[5], o[6], o[7]}; }
        LDS_WAIT(); asm volatile("" ::: "memory");
        ci = ni;
#pragma unroll
        for (int i = 0; i < 8; ++i) cur[i] = nxt[i];
    }
}
__device__ __forceinline__ void p0_ada_task(Frame& F, int j) {
    LAS float* s = (LAS float*)F.lds;
    LAS float* red = (LAS float*)(F.lds + 9 * 1024 * 4);
    for (int i = F.tid; i < 9 * 1024; i += NTHR) { const int r = i >> 10, k = i & 1023; const float c = (r < 8) ? F.in[I_C][r * 1024 + k] : F.in[I_CCTX][k]; s[i] = c * sigmoidf_(c); }
    __syncthreads();
    const float* aw = F.in[I_ADAW] + (size_t)(128 * F.wave) * 6144 + 64 * j + F.lane;
    float acc[9];
#pragma unroll
    for (int r = 0; r < 9; ++r) acc[r] = 0.f;
    for (int k0 = 0; k0 < 128; k0 += 8) {
        float a[8];
#pragma unroll
        for (int u = 0; u < 8; ++u) a[u] = aw[(size_t)(k0 + u) * 6144];
#pragma unroll
        for (int u = 0; u < 8; ++u)
#pragma unroll
            for (int r = 0; r < 9; ++r) acc[r] += s[r * 1024 + 128 * F.wave + k0 + u] * a[u];
    }
#pragma unroll
    for (int r = 0; r < 9; ++r) red[(F.wave * 9 + r) * 64 + F.lane] = acc[r];
    __syncthreads();
    float* mod = (float*)(F.ws + WS_MOD);
    for (int i = F.tid; i < 9 * 64; i += NTHR) { const int r = i >> 6, l = i & 63; float v = F.in[I_ADAB][64 * j + l];
#pragma unroll
        for (int w = 0; w < 8; ++w) v += red[(w * 9 + r) * 64 + l];
        mod[r * 6144 + 64 * j + l] = v; }
    __syncthreads();
}
__device__ __forceinline__ void p0_prologue(Frame& F, int p0mask) {
    __syncthreads();
    if (p0mask & 1) {
    const int gtid = F.bid * NTHR + F.tid, NGT = F.G * NTHR;
    for (int j = F.bid; j < 96; j += F.G) p0_ada_task(F, j);
    if (F.bid == (96 % F.G)) { float* lb = (float*)(F.ws + WS_LB); for (int i = F.tid; i < 2 * HW; i += NTHR) { const float a = F.in[I_LB][i], b = F.in[I_LB][2 * HW + i]; lb[i] = 1.0f / (1.0f + __expf(b - a)); } }
    { float* pos = (float*)(F.ws + WS_POS);
      for (int i = gtid; i < SEQ * D; i += NGT) { const int l = i >> 10, c = i & 1023, q = c >> 8, j = c & 255;
          const float om = exp2f(-(float)j * (13.287712379549449f / 256.0f)); const float p = (float)((q < 2) ? (l >> 6) : (l & 63)); const float ang = p * om;
          pos[i] = (q & 1) ? cosf(ang) : sinf(ang); } }
    { float* mg = (float*)(F.ws + WS_MG);
      for (int i = gtid; i < NG * GD * 2 * GD; i += NGT) { const int j = i & 255, c = (i >> 8) & 127, g = i >> 15; const int jj = j & 127; const bool isS = j >= 128;
          const float* fw = F.in[I_FNW] + (size_t)g * GD * GD + jj; float acc = 0.f;
          for (int cp = 0; cp < GD; ++cp) { const int m = (c * cp) & 127; float sv, cv; sincospif((float)m * (1.0f / 64.0f), &sv, &cv); acc += (isS ? sv : cv) * fw[cp * GD]; }
          mg[i] = acc * 0.08838834764831845f; } }
    { bf16* dc = (bf16*)(F.ws + WS_DFT); bf16* ds = dc + (size_t)SEQ * SEQ;
      for (int i = gtid; i < SEQ * SEQ / 8; i += NGT) { const int k = i >> 8, l0 = (i & 255) * 8; float cv[8], sv[8];
#pragma unroll
          for (int u = 0; u < 8; ++u) { const int m = (k * (l0 + u)) & 2047; sincospif((float)m * (1.0f / 1024.0f), &sv[u], &cv[u]); cv[u] *= 0.022097086912079608f; sv[u] *= 0.022097086912079608f; }
          v4u a, b; a.x = pk2(cv[0], cv[1]); a.y = pk2(cv[2], cv[3]); a.z = pk2(cv[4], cv[5]); a.w = pk2(cv[6], cv[7]);
          b.x = pk2(sv[0], sv[1]); b.y = pk2(sv[2], sv[3]); b.z = pk2(sv[4], sv[5]); b.w = pk2(sv[6], sv[7]);
          *(v4u*)(dc + (size_t)k * SEQ + l0) = a; *(v4u*)(ds + (size_t)k * SEQ + l0) = b; } }
    }
    if (!(p0mask & 2)) return;
    LAS float* scr = (LAS float*)(F.lds + F.wave * 16384);
    const int gw = F.bid * NWAVES + F.wave, NGW = F.G * NWAVES;
    constexpr int I_IN = 16 * (NPX / 32), I_OUT = 16 * 32;
    for (int it = gw; it < I_IN + I_OUT; it += NGW) {
        if (it < I_IN) p0_transpose_item(F.in[I_WIN], 3072, D, NPX / 32, (bf16*)(F.ws + WS_WINT), scr, it, F.lane);
        else p0_transpose_item(F.in[I_WOUT], D, D, 32, (bf16*)(F.ws + WS_WOUT), scr, it - I_IN, F.lane);
    }
    p0_fp8_items(F, scr, gw, NGW, NE * 1024 + NE * 512);
}

#define P1_LOAD(t, vv, pp) do { const bool lat_ = (t) < T; \
        const GAS f32x4* xr_ = (const GAS f32x4*)(lat_ ? F.in[I_X] + (size_t)(t) * D : F.in[I_CTX] + (size_t)((t) - T) * D) + F.lane; \
        const GAS f32x4* pr_ = (const GAS f32x4*)((const float*)(F.ws + WS_POS) + (size_t)((t) & (SEQ - 1)) * D) + F.lane; \
        _Pragma("unroll") for (int j = 0; j < 4; ++j) { vv[j] = xr_[64 * j]; pp[j] = lat_ ? pr_[64 * j] : (f32x4){0.f, 0.f, 0.f, 0.f}; } } while (0)
__device__ __forceinline__ void p1_rows(Frame& F, int first, int stride) {
    const float* mod = (const float*)(F.ws + WS_MOD); const float* g1 = F.in[I_N1G];
    f32x4 v[4], p[4], nv[4], np[4];
    int t = first; if (t >= TA) return;
    P1_LOAD(t, v, p);
    for (; t < TA; t += stride) {
        const int tn = t + stride;
        if (tn < TA) P1_LOAD(tn, nv, np);
        const int b = (t < T) ? (t >> 11) : 8;
        float ss = 0.f;
#pragma unroll
        for (int j = 0; j < 4; ++j) { v[j] = v[j] + p[j]; ss += (v[j].x * v[j].x + v[j].y * v[j].y) + (v[j].z * v[j].z + v[j].w * v[j].w); }
        const float rinv = 1.0f / sqrtf(wave_sum(ss) * (1.0f / D) + NORM_EPS);
        GAS unsigned long long* o8 = (GAS unsigned long long*)((bf16*)(F.ws + WS_HMOD) + (size_t)t * D) + F.lane;
#pragma unroll
        for (int j = 0; j < 4; ++j) { const int c = 4 * F.lane + 256 * j;
            const f32x4 g = *(const f32x4*)(g1 + c), sh = *(const f32x4*)(mod + b * 6144 + c), sc = *(const f32x4*)(mod + b * 6144 + D + c);
            const f32x4 h = v[j] * rinv * g * (sc + 1.0f) + sh;
            o8[64 * j] = (unsigned long long)pk2(h.x, h.y) | ((unsigned long long)pk2(h.z, h.w) << 32); }
#pragma unroll
        for (int j = 0; j < 4; ++j) { v[j] = nv[j]; p[j] = np[j]; }
    }
}
__device__ __forceinline__ void p1_fold_task(Frame& F, int task) {
    const int kb = task & 15, pq = (task >> 4) & 1, g = task >> 5, k0 = 64 * kb;
    LAS float* wt = (LAS float*)F.lds;
    LAS float* mh = (LAS float*)(F.lds + 64 * 129 * 4);
    const float* mg = (const float*)(F.ws + WS_MG) + (size_t)g * GD * 256 + pq * 128;
    for (int i = F.tid; i < 64 * 128; i += NTHR) { const int kk = i >> 7, c = i & 127; wt[kk * 129 + c] = F.in[I_WIN][(size_t)(k0 + kk) * 3072 + NPX + g * GD + c]; }
    for (int i = F.tid; i < 128 * 128; i += NTHR) { const int c = i >> 7, j = i & 127; mh[i] = mg[c * 256 + j]; }
    __syncthreads();
    const int kk = F.tid & 63, jg = F.tid >> 6;
    float acc[16];
#pragma unroll
    for (int i = 0; i < 16; ++i) acc[i] = 0.f;
    for (int c = 0; c < 128; ++c) { const float w = wt[kk * 129 + c]; const LAS f32x4* m4 = (const LAS f32x4*)(mh + c * 128 + jg * 16);
#pragma unroll
        for (int q = 0; q < 4; ++q) { const f32x4 mv = m4[q]; acc[4 * q] += w * mv.x; acc[4 * q + 1] += w * mv.y; acc[4 * q + 2] += w * mv.z; acc[4 * q + 3] += w * mv.w; } }
    bf16* wf = (bf16*)(F.ws + WS_WINT) + (size_t)NPX * D;
#pragma unroll
    for (int i = 0; i < 16; ++i) wf[(size_t)(pq * 512 + g * GD + jg * 16 + i) * D + k0 + kk] = (bf16)f2bf(acc[i]);
    __syncthreads();
}
__device__ __forceinline__ void p1_phase(Frame& F) {
    for (int task = F.bid; task < 128; task += F.G) p1_fold_task(F, task);
    const int gw = F.bid * NWAVES + F.wave, NGW = F.G * NWAVES;
    p1_rows(F, gw, NGW);
}

struct SchedInproj {
    int G, c; const char* hmod; const char* wint; char* px; char* pt;
    __device__ __forceinline__ bool next(int i, pg8::Unit& u) const {
        const int L = i * G + c;
        if (L < 720) { int pm, pn; pg8::tile_of(L, 72, 10, pm, pn);
            u.a = hmod + (size_t)pm * 256 * D * 2; u.b = wint + (size_t)pn * 256 * D * 2; u.o = px + ((size_t)pm * 256 * NPX + (size_t)pn * 256) * 2; u.i0 = NPX; u.i1 = u.i2 = u.i3 = 0; return true; }
        if (L < 976) { int pm, pn; pg8::tile_of(L - 720, 4, 64, pm, pn);
            const int pq = pm >> 1, c0 = (pm & 1) * 256, b = pn >> 3, l0 = (pn & 7) * 256;
            u.a = wint + (size_t)(NPX + pm * 256) * D * 2; u.b = hmod + (size_t)pn * 256 * D * 2;
            u.o = pt + ((((size_t)(pq * 8 + b) * 512 + c0) * SEQ) + l0) * 2; u.i0 = SEQ; u.i1 = u.i2 = u.i3 = 0; return true; }
        return false;
    }
};
namespace gla {
constexpr int GP = 272, GP64 = 144;
constexpr int L_QI = 0, L_KI = L_QI + 64 * GP, L_KIT = L_KI + 64 * GP, L_VT = L_KIT + 128 * GP64, L_TT = L_VT + 32 * GP64, L_P = L_TT + 32 * GP, L_TOT = L_P + 64 * GP64, L_C = L_TOT + 4096, L_END = L_C + 1024;
static_assert(L_END <= RING_BYTES, "gla lds");
}
#define GLA_MFMA(a, b, c) __builtin_amdgcn_mfma_f32_16x16x32_bf16((a), (b), (c), 0, 0, 0)
__device__ __forceinline__ void p3_gla_chunked(Frame& F, int chain) {
    using namespace gla;
    const int vq = chain & 3, dir = (chain >> 2) & 1, h = (chain >> 3) & 3, b = chain >> 5;
    LAS unsigned char* L = F.lds;
    const bf16* px = (const bf16*)(F.ws + WS_PX);
    const float* lbp = (const float*)(F.ws + WS_LB) + dir * HW + h * HD;
    float* og = (float*)(F.ws + WS_OGLA) + (size_t)dir * T * HW;
    const int lane = F.lane, w = F.wave, g = lane >> 4, li = lane & 15;
    const int zcol = 3 * HW + dir * HW + h * HD + 2 * lane, qcol = h * HD + 2 * lane, vcol = HW + h * HD + vq * 32 + (F.tid & 7) * 4;
    const float lb0 = lbp[2 * lane], lb1 = lbp[2 * lane + 1];
    f32x4 S0 = (f32x4){0.f, 0.f, 0.f, 0.f}, S1 = (f32x4){0.f, 0.f, 0.f, 0.f};
    constexpr int NBLK = (CTX + SEQ) / 64;
    unsigned zr[8], qr[8]; v2u vr;
#define GLA_ROWBASE(blk) (((blk) < CTX / 64) ? (size_t)(T + b * CTX + ((dir == 0) ? (blk) * 64 : (CTX - 64 - (blk) * 64))) : (size_t)(b * SEQ + ((dir == 0) ? ((blk) - CTX / 64) * 64 : (SEQ - 64 - ((blk) - CTX / 64) * 64))))
#define GLA_LOAD(blk) do { const size_t rb_ = GLA_ROWBASE(blk); const bool lat_ = (blk) >= CTX / 64; \
        _Pragma("unroll") for (int i = 0; i < 8; ++i) { const int tl = 8 * w + i; const bf16* pr = px + (rb_ + (dir ? 63 - tl : tl)) * NPX; zr[i] = *(const unsigned*)(pr + zcol); qr[i] = lat_ ? *(const unsigned*)(pr + qcol) : 0u; } \
        { const int tl = F.tid >> 3; vr = *(const v2u*)(px + (rb_ + (dir ? 63 - tl : tl)) * NPX + vcol); } } while (0)
    GLA_LOAD(0);
    for (int blk = 0; blk < NBLK; ++blk) {
        const bool lat = blk >= CTX / 64;
        const size_t rowbase = GLA_ROWBASE(blk);
        float c0[8], c1[8], k0[8], k1[8], q0[8], q1[8];
        { float a0 = 0.f, a1 = 0.f;
#pragma unroll
          for (int i = 0; i < 8; ++i) { const float f0 = lb0 + (1.0f - lb0) * sigmoidf_(bflo(zr[i])), f1 = lb1 + (1.0f - lb1) * sigmoidf_(bfhi(zr[i]));
              a0 += __logf(f0); a1 += __logf(f1); c0[i] = a0; c1[i] = a1; k0[i] = 1.0f - f0; k1[i] = 1.0f - f1; q0[i] = bflo(qr[i]); q1[i] = bfhi(qr[i]); }
          *(LAS f32x2*)(L + L_TOT + (w * 128 + 2 * lane) * 4) = (f32x2){a0, a1}; }
        const v2u vcur = vr;
        if (blk + 1 < NBLK) GLA_LOAD(blk + 1);
        __syncthreads();
        { float pre0 = 0.f, pre1 = 0.f, br0 = 0.f, br1 = 0.f, bl0 = 0.f, bl1 = 0.f;
#pragma unroll
          for (int t2 = 0; t2 < 8; ++t2) { const f32x2 tt = *(const LAS f32x2*)(L + L_TOT + (t2 * 128 + 2 * lane) * 4);
              if (t2 < w) { pre0 += tt.x; pre1 += tt.y; } if (t2 < 4) { br0 += tt.x; br1 += tt.y; } bl0 += tt.x; bl1 += tt.y; }
          unsigned kp0[4], kp1[4];
#pragma unroll
          for (int i = 0; i < 8; i += 2) {
              const float ea0 = __expf(pre0 + c0[i] - br0), ea1 = __expf(pre1 + c1[i] - br1), eb0 = __expf(pre0 + c0[i + 1] - br0), eb1 = __expf(pre1 + c1[i + 1] - br1);
              const float ka0 = k0[i] * __builtin_amdgcn_rcpf(ea0), ka1 = k1[i] * __builtin_amdgcn_rcpf(ea1), kb0 = k0[i + 1] * __builtin_amdgcn_rcpf(eb0), kb1 = k1[i + 1] * __builtin_amdgcn_rcpf(eb1);
              const int t = 8 * w + i;
              if (lat) { *(LAS unsigned*)(L + L_QI + t * GP + 4 * lane) = pg8::cvt_pk_bf16(q0[i] * ea0, q1[i] * ea1); *(LAS unsigned*)(L + L_QI + (t + 1) * GP + 4 * lane) = pg8::cvt_pk_bf16(q0[i + 1] * eb0, q1[i + 1] * eb1);
                         *(LAS unsigned*)(L + L_KI + t * GP + 4 * lane) = pg8::cvt_pk_bf16(ka0, ka1); *(LAS unsigned*)(L + L_KI + (t + 1) * GP + 4 * lane) = pg8::cvt_pk_bf16(kb0, kb1); }
              kp0[i >> 1] = pg8::cvt_pk_bf16(ka0, kb0); kp1[i >> 1] = pg8::cvt_pk_bf16(ka1, kb1); }
          *(LAS v4u*)(L + L_KIT + (2 * lane) * GP64 + w * 16) = (v4u){kp0[0], kp0[1], kp0[2], kp0[3]};
          *(LAS v4u*)(L + L_KIT + (2 * lane + 1) * GP64 + w * 16) = (v4u){kp1[0], kp1[1], kp1[2], kp1[3]};
          if (w == 0) { *(LAS f32x2*)(L + L_C + 2 * lane * 4) = (f32x2){__expf(br0), __expf(br1)}; *(LAS f32x2*)(L + L_C + (128 + 2 * lane) * 4) = (f32x2){__expf(bl0 - br0), __expf(bl1 - br1)}; } }
        { const int tl = F.tid >> 3, c4 = (F.tid & 7) * 4;
          *(LAS unsigned short*)(L + L_VT + (c4 + 0) * GP64 + tl * 2) = (unsigned short)(vcur.x & 0xffffu); *(LAS unsigned short*)(L + L_VT + (c4 + 1) * GP64 + tl * 2) = (unsigned short)(vcur.x >> 16);
          *(LAS unsigned short*)(L + L_VT + (c4 + 2) * GP64 + tl * 2) = (unsigned short)(vcur.y & 0xffffu); *(LAS unsigned short*)(L + L_VT + (c4 + 3) * GP64 + tl * 2) = (unsigned short)(vcur.y >> 16); }
        __syncthreads();
        const f32x4 c1v = *(const LAS f32x4*)(L + L_C + (16 * w + 4 * g) * 4), c2v = *(const LAS f32x4*)(L + L_C + (128 + 16 * w + 4 * g) * 4);
        const f32x4 T0 = S0 * c1v, T1 = S1 * c1v;
        if (lat) {
            *(LAS v2u*)(L + L_TT + li * GP + (16 * w + 4 * g) * 2) = (v2u){pg8::cvt_pk_bf16(T0.x, T0.y), pg8::cvt_pk_bf16(T0.z, T0.w)};
            *(LAS v2u*)(L + L_TT + (16 + li) * GP + (16 * w + 4 * g) * 2) = (v2u){pg8::cvt_pk_bf16(T1.x, T1.y), pg8::cvt_pk_bf16(T1.z, T1.w)};
            const int ti = w & 3;
#pragma unroll
            for (int jj = 0; jj < 2; ++jj) { const int tj = 2 * (w >> 2) + jj; f32x4 acc = (f32x4){0.f, 0.f, 0.f, 0.f};
                if (tj <= ti) {
#pragma unroll
                    for (int ks = 0; ks < 4; ++ks) { const bf16x8 a = *(const LAS bf16x8*)(L + L_QI + (16 * ti + li) * GP + ks * 64 + g * 16), bb = *(const LAS bf16x8*)(L + L_KI + (16 * tj + li) * GP + ks * 64 + g * 16); acc = GLA_MFMA(a, bb, acc); } }
#pragma unroll
                for (int r = 0; r < 4; ++r) { const bool keep = (tj < ti) || (tj == ti && li <= 4 * g + r); const float val = keep ? acc[r] : 0.0f;
                    *(LAS unsigned short*)(L + L_P + (16 * ti + 4 * g + r) * GP64 + (16 * tj + li) * 2) = (unsigned short)f2bf(val); } }
        }
        __syncthreads();
        if (lat) { const int ti = w & 3, vj = w >> 2; f32x4 acc = (f32x4){0.f, 0.f, 0.f, 0.f};
#pragma unroll
            for (int ks = 0; ks < 2; ++ks) { const bf16x8 a = *(const LAS bf16x8*)(L + L_P + (16 * ti + li) * GP64 + ks * 64 + g * 16), bb = *(const LAS bf16x8*)(L + L_VT + (16 * vj + li) * GP64 + ks * 64 + g * 16); acc = GLA_MFMA(a, bb, acc); }
#pragma unroll
            for (int ks = 0; ks < 4; ++ks) { const bf16x8 a = *(const LAS bf16x8*)(L + L_QI + (16 * ti + li) * GP + ks * 64 + g * 16), bb = *(const LAS bf16x8*)(L + L_TT + (16 * vj + li) * GP + ks * 64 + g * 16); acc = GLA_MFMA(a, bb, acc); }
#pragma unroll
            for (int r = 0; r < 4; ++r) { const int tl = 16 * ti + 4 * g + r; og[(rowbase + (dir ? 63 - tl : tl)) * HW + h * HD + vq * 32 + 16 * vj + li] = acc[r]; } }
        { f32x4 a0 = T0, a1 = T1;
#pragma unroll
          for (int ks = 0; ks < 2; ++ks) { const bf16x8 a = *(const LAS bf16x8*)(L + L_KIT + (16 * w + li) * GP64 + ks * 64 + g * 16);
              const bf16x8 b0 = *(const LAS bf16x8*)(L + L_VT + li * GP64 + ks * 64 + g * 16), b1 = *(const LAS bf16x8*)(L + L_VT + (16 + li) * GP64 + ks * 64 + g * 16);
              a0 = GLA_MFMA(a, b0, a0); a1 = GLA_MFMA(a, b1, a1); }
          S0 = a0 * c2v; S1 = a1 * c2v; }
        __syncthreads();
    }
#undef GLA_LOAD
#undef GLA_ROWBASE
}
struct SchedFourier {
    int G, c; const char* dft; const char* pt; char* eo;
    __device__ __forceinline__ bool next(int i, pg8::Unit& u) const {
        const int L = i * G + c; if (L >= 256) return false;
        const int b = L & 7, r = L >> 3, kt = r >> 2, pn = r & 3, pq = pn >> 1;
        u.a = dft + ((size_t)pq * SEQ * SEQ + (size_t)kt * 256 * SEQ) * 2;
        u.b = pt + (((size_t)(pq * 8 + b) * 512 + (pn & 1) * 256) * SEQ) * 2;
        u.o = eo + (((size_t)b * SEQ + kt * 256) * D + pn * 256) * 2; u.i0 = D; u.i1 = u.i2 = u.i3 = 0; return true;
    }
};
struct P3cRaw { f32x4 a0, a1, b0, b1; v4u gz, e, q; };
__device__ __forceinline__ P3cRaw p3c_load(Frame& F, int t) {
    P3cRaw r; const float* o0 = (const float*)(F.ws + WS_OGLA) + (size_t)t * HW + 8 * F.lane; const float* o1 = o0 + (size_t)T * HW;
    r.a0 = *(const GAS f32x4*)o0; r.a1 = *(const GAS f32x4*)(o0 + 4); r.b0 = *(const GAS f32x4*)o1; r.b1 = *(const GAS f32x4*)(o1 + 4);
    r.gz = *(const GAS v4u*)((const bf16*)(F.ws + WS_PX) + (size_t)t * NPX + 2 * HW + 8 * F.lane);
    const bf16* eo = (const bf16*)(F.ws + WS_EO) + (size_t)t * D + 8 * F.lane; r.e = *(const GAS v4u*)eo; r.q = *(const GAS v4u*)(eo + 512);
    return r;
}
__device__ __forceinline__ void p3c_compute(Frame& F, int t, const P3cRaw& r) {
    float o[8] = {r.a0.x + r.b0.x, r.a0.y + r.b0.y, r.a0.z + r.b0.z, r.a0.w + r.b0.w, r.a1.x + r.b1.x, r.a1.y + r.b1.y, r.a1.z + r.b1.z, r.a1.w + r.b1.w};
    float ss = 0.f;
#pragma unroll
    for (int i = 0; i < 8; ++i) ss += o[i] * o[i];
    ss += __shfl_xor(ss, 1); ss += __shfl_xor(ss, 2); ss += __shfl_xor(ss, 4); ss += __shfl_xor(ss, 8);
    const float rinv = 1.0f / sqrtf(ss * (1.0f / HD) + NORM_EPS);
    const float* gn = F.in[I_GN] + ((8 * F.lane) & 127);
    const unsigned gg[4] = {r.gz.x, r.gz.y, r.gz.z, r.gz.w};
    float hx[8];
#pragma unroll
    for (int u = 0; u < 4; ++u) { hx[2 * u] = o[2 * u] * rinv * gn[2 * u] * sigmoidf_(bflo(gg[u])); hx[2 * u + 1] = o[2 * u + 1] * rinv * gn[2 * u + 1] * sigmoidf_(bfhi(gg[u])); }
    bf16* mix = (bf16*)(F.ws + WS_MIX) + (size_t)t * D;
    v4u w; w.x = pk2(hx[0], hx[1]); w.y = pk2(hx[2], hx[3]); w.z = pk2(hx[4], hx[5]); w.w = pk2(hx[6], hx[7]);
    *(GAS v4u*)(mix + 8 * F.lane) = w;
    const v4u e = r.e, q = r.q;
    v4u f; f.x = pk2(bflo(e.x) - bflo(q.x), bfhi(e.x) - bfhi(q.x)); f.y = pk2(bflo(e.y) - bflo(q.y), bfhi(e.y) - bfhi(q.y));
    f.z = pk2(bflo(e.z) - bflo(q.z), bfhi(e.z) - bfhi(q.z)); f.w = pk2(bflo(e.w) - bflo(q.w), bfhi(e.w) - bfhi(q.w));
    *(GAS v4u*)(mix + HW + 8 * F.lane) = f;
}
__device__ __forceinline__ void p3c_rows(Frame& F, int first, int stride) {
    int t = first; if (t >= T) return;
    P3cRaw cur = p3c_load(F, t);
    for (; t < T; t += stride) { const int tn = t + stride; P3cRaw nx = cur; if (tn < T) nx = p3c_load(F, tn); p3c_compute(F, t, cur); cur = nx; }
}
struct SchedWout {
    int G, c; const char* mix; const char* wout;
    __device__ __forceinline__ bool next(int i, pg8::Unit& u) const {
        const int L = i * G + c; if (L >= 256) return false;
        int pm, pn; pg8::tile_of(L, 64, 4, pm, pn);
        u.a = mix + (size_t)pm * 256 * D * 2; u.b = wout + (size_t)pn * 256 * D * 2; u.o = nullptr; u.i0 = pm * 256; u.i1 = pn * 256; u.i2 = u.i3 = 0; return true;
    }
};
__device__ __forceinline__ void p5a_phase(Frame& F, int cw_cnt) {
    LAS float* wrT = (LAS float*)F.lds;
    volatile LAS unsigned* lcnt = F.MISC + 16;
    volatile LAS unsigned* lbase = F.MISC + 48;
    const float* rw = F.in[I_RW];
    for (int i = F.tid; i < D * NE; i += NTHR) { const int k = i >> 5, e = i & 31; wrT[e * 1024 + ((((k >> 2) ^ (e & 7)) << 2) | (k & 3))] = rw[i]; }
    const float* mod = (const float*)(F.ws + WS_MOD); const float* g2 = F.in[I_N2G];
    int* tok_e = (int*)(F.ws + WS_ROUTE); int* tok_pos = tok_e + T * 4; float* tok_w = (float*)(tok_pos + T * 4);
    for (int base = F.bid * 64; base < T; base += F.G * 64) {
        if (F.tid < 32) lcnt[F.tid] = 0u;
        __syncthreads();
        int my_e = 0; unsigned my_rank = 0; float my_w = 0.f;
        f32x4 nv[4];
        { const GAS f32x4* xr = (const GAS f32x4*)((const float*)(F.ws + WS_X2) + (size_t)(base + F.wave * 8) * D) + F.lane;
#pragma unroll
          for (int j = 0; j < 4; ++j) nv[j] = xr[64 * j]; }
#pragma unroll 1
        for (int i = 0; i < 8; ++i) {
            const int t = base + F.wave * 8 + i; const int b = t >> 11;
            f32x4 v[4]; float ss = 0.f;
#pragma unroll
            for (int j = 0; j < 4; ++j) { v[j] = nv[j]; ss += (v[j].x * v[j].x + v[j].y * v[j].y) + (v[j].z * v[j].z + v[j].w * v[j].w); }
            if (i < 7) { const GAS f32x4* xr = (const GAS f32x4*)((const float*)(F.ws + WS_X2) + (size_t)(t + 1) * D) + F.lane;
#pragma unroll
                for (int j = 0; j < 4; ++j) nv[j] = xr[64 * j]; }
            const float rinv = 1.0f / sqrtf(wave_sum(ss) * (1.0f / D) + NORM_EPS);
            GAS unsigned* o4 = (GAS unsigned*)(F.ws + WS_HM + (size_t)t * D) + F.lane;
#pragma unroll
            for (int j = 0; j < 4; ++j) { const int c = 4 * F.lane + 256 * j;
                const f32x4 g = *(const f32x4*)(g2 + c), sh = *(const f32x4*)(mod + b * 6144 + 3 * D + c), sc = *(const f32x4*)(mod + b * 6144 + 4 * D + c);
                v[j] = v[j] * rinv * g * (sc + 1.0f) + sh;
                o4[64 * j] = pk4_fp8(SC_HM * v[j].x, SC_HM * v[j].y, SC_HM * v[j].z, SC_HM * v[j].w); }
            float acc[32];
#pragma unroll
            for (int e = 0; e < 32; ++e) { float a = 0.f;
                if ((e & 3) == 0) asm volatile("" ::: "memory");
#pragma unroll
                for (int j = 0; j < 4; ++j) { const f32x4 w = *(const LAS f32x4*)(wrT + e * 1024 + 4 * ((F.lane + 64 * j) ^ (e & 7))); a += v[j].x * w.x + v[j].y * w.y + v[j].z * w.z + v[j].w * w.w; }
                acc[e] = a; }
#define P5_HALVE(N, MASK) _Pragma("unroll") for (int j = 0; j < N; ++j) { const bool hi = (F.lane & MASK) != 0; const float keep = hi ? acc[j + N] : acc[j]; const float send = hi ? acc[j] : acc[j + N]; acc[j] = keep + __shfl_xor(send, MASK); }
            P5_HALVE(16, 32) P5_HALVE(8, 16) P5_HALVE(4, 8) P5_HALVE(2, 4) P5_HALVE(1, 2)
#undef P5_HALVE
            float lg = acc[0] + __shfl_xor(acc[0], 1);
            const int e_me = F.lane >> 1;
            lg += F.in[I_RB][e_me];
            float tv0, tv1, tv2, tv3; int te0, te1, te2, te3;
#define P5_TOP(TV, TE) { const float m = wave_max(lg); const unsigned long long bal = __ballot(lg == m); const int ln = __ffsll((long long)bal) - 1; TE = ln >> 1; TV = m; if (e_me == TE) lg = -3.0e38f; }
            P5_TOP(tv0, te0) P5_TOP(tv1, te1) P5_TOP(tv2, te2) P5_TOP(tv3, te3)
#undef P5_TOP
            const float e1 = __expf(tv1 - tv0), e2 = __expf(tv2 - tv0), e3 = __expf(tv3 - tv0); const float inv = 1.0f / (1.0f + e1 + e2 + e3);
            if ((F.lane >> 2) == i && F.lane < 32) { const int k = F.lane & 3; my_e = te0; my_w = inv;
                if (k == 1) { my_e = te1; my_w = e1 * inv; } if (k == 2) { my_e = te2; my_w = e2 * inv; } if (k == 3) { my_e = te3; my_w = e3 * inv; } }
        }
        if (F.lane < 32) my_rank = __hip_atomic_fetch_add((LAS unsigned*)lcnt + my_e, 1u, __ATOMIC_RELAXED, __HIP_MEMORY_SCOPE_WORKGROUP);
        __syncthreads();
        if (F.tid < 32) lbase[F.tid] = __hip_atomic_fetch_add((unsigned*)(F.ctl + cw_cnt) + F.tid, lcnt[F.tid], __ATOMIC_RELAXED, __HIP_MEMORY_SCOPE_AGENT);
        __syncthreads();
        if (F.lane < 32) { const int t = base + F.wave * 8 + (F.lane >> 2); const int idx = t * 4 + (F.lane & 3);
            tok_e[idx] = my_e; tok_pos[idx] = (int)(lbase[my_e] + my_rank); tok_w[idx] = my_w; }
        __syncthreads();
    }
}
__device__ __forceinline__ void moe_offsets(Frame& F, volatile LAS unsigned* boff) {
    if (F.tid == 0) { unsigned acc = 0; for (int e = 0; e < NE; ++e) { boff[e] = acc; acc += (((const unsigned*)(F.ctl + CW_CNT))[e] + 255u) >> 8; } boff[NE] = acc; }
    __syncthreads();
}
__device__ __forceinline__ void p5c_phase(Frame& F) {
    volatile LAS unsigned* boff = F.MISC + 16;
    moe_offsets(F, boff);
    const int* tok_e = (const int*)(F.ws + WS_ROUTE); const int* tok_pos = tok_e + T * 4; int* tok_slot = (int*)(F.ws + WS_ROUTE) + 3 * T * 4;
    const int gw = F.bid * NWAVES + F.wave, NGW = F.G * NWAVES;
    for (int t = gw; t < T; t += NGW) {
        const v4u r0 = *((const GAS v4u*)(F.ws + WS_HM + (size_t)t * D) + F.lane);
#pragma unroll
        for (int k = 0; k < 4; ++k) { const int e = tok_e[t * 4 + k]; const int slot = (int)(boff[e] * 256u) + tok_pos[t * 4 + k];
            *((GAS v4u*)(F.ws + WS_HMP + (size_t)slot * D) + F.lane) = r0;
            if (F.lane == 0) tok_slot[t * 4 + k] = slot; }
    }
}
template <int NPN, int MODE>
struct SchedMoe {
    int r, nmem, x; unsigned n0, n1, n2, n3, b0, b1, b2, b3; const char* A; const char* B;
    __device__ __forceinline__ void init(Frame& F, volatile LAS unsigned* boff, const char* A_, const char* B_) {
        x = F.bid & 7; r = F.bid >> 3; nmem = (F.G + 7 - x) / 8; A = A_; B = B_;
        b0 = boff[x]; n0 = boff[x + 1] - b0; b1 = boff[x + 8]; n1 = boff[x + 9] - b1; b2 = boff[x + 16]; n2 = boff[x + 17] - b2; b3 = boff[x + 24]; n3 = boff[x + 25] - b3;
        if ((F.G & 7) != 0) { nmem = 0; }
    }
    __device__ __forceinline__ bool next(int i, pg8::Unit& u) const {
        if (nmem == 0) return false;
        const unsigned j = (unsigned)(i * nmem + r); unsigned blk = j / NPN; const int pn = (int)(j % NPN);
        int e; unsigned gb;
        if (blk < n0) { e = x; gb = b0 + blk; }
        else { blk -= n0;
            if (blk < n1) { e = x + 8; gb = b1 + blk; }
            else { blk -= n1;
                if (blk < n2) { e = x + 16; gb = b2 + blk; }
                else { blk -= n2; if (blk >= n3) return false; e = x + 24; gb = b3 + blk; } } }
        u.a = A + (size_t)gb * 256 * D;
        if (MODE == 1) u.b = B + ((size_t)e * 2 * DFF + (size_t)pn * 128) * D; else u.b = B + ((size_t)e * D + (size_t)pn * 256) * DFF;
        u.o = nullptr; u.i0 = (int)gb * 256; u.i1 = pn; u.i2 = e; u.i3 = 0; return true;
    }
};
struct P8Raw { f32x4 x[4]; v2u y[4][4]; float w[4]; };
__device__ __forceinline__ void p8_route(Frame& F, int t, int (&slot)[4], float (&w)[4]) {
    const int* tok_slot = (const int*)(F.ws + WS_ROUTE) + 3 * T * 4; const float* tok_w = (const float*)(F.ws + WS_ROUTE) + 2 * T * 4;
    const int k = F.lane & 3; const int sv = *(const GAS int*)(tok_slot + t * 4 + k); const float wv = *(const GAS float*)(tok_w + t * 4 + k);
#pragma unroll
    for (int q = 0; q < 4; ++q) { slot[q] = __shfl(sv, q); w[q] = __shfl(wv, q); }
}
__device__ __forceinline__ void p8_load(Frame& F, int t, const int (&slot)[4], const float (&w)[4], P8Raw& r) {
    const GAS f32x4* xr = (const GAS f32x4*)((const float*)(F.ws + WS_X2) + (size_t)t * D) + F.lane;
#pragma unroll
    for (int j = 0; j < 4; ++j) r.x[j] = xr[64 * j];
#pragma unroll
    for (int k = 0; k < 4; ++k) { const GAS v2u* yr = (const GAS v2u*)((const bf16*)(F.ws + WS_YS) + (size_t)slot[k] * D) + F.lane; r.w[k] = w[k];
#pragma unroll
        for (int j = 0; j < 4; ++j) r.y[k][j] = yr[64 * j]; }
}
__device__ __forceinline__ void p8_compute(Frame& F, int t, const P8Raw& r) {
    const int b = t >> 11; const float* mod = (const float*)(F.ws + WS_MOD);
    f32x4 v[4], m[4];
#pragma unroll
    for (int j = 0; j < 4; ++j) { v[j] = r.x[j]; m[j] = (f32x4){0.f, 0.f, 0.f, 0.f}; }
#pragma unroll
    for (int k = 0; k < 4; ++k) { const float w = r.w[k];
#pragma unroll
        for (int j = 0; j < 4; ++j) { const v2u y = r.y[k][j]; m[j].x += w * bflo(y.x); m[j].y += w * bfhi(y.x); m[j].z += w * bflo(y.y); m[j].w += w * bfhi(y.y); } }
    float ss = 0.f;
#pragma unroll
    for (int j = 0; j < 4; ++j) { const f32x4 g = *(const f32x4*)(mod + b * 6144 + 5 * D + 4 * F.lane + 256 * j); v[j] = v[j] + g * m[j];
        ss += (v[j].x * v[j].x + v[j].y * v[j].y) + (v[j].z * v[j].z + v[j].w * v[j].w); }
    const float rinv = 1.0f / sqrtf(wave_sum(ss) * (1.0f / D) + NORM_EPS);
    GAS f32x4* orow = (GAS f32x4*)(F.out + (size_t)t * D) + F.lane;
#pragma unroll
    for (int j = 0; j < 4; ++j) { const f32x4 g = *(const f32x4*)(F.in[I_FG] + 4 * F.lane + 256 * j); orow[64 * j] = v[j] * rinv * g; }
}
__device__ __forceinline__ void p8_rows(Frame& F, int first, int stride) {
    int t = first; if (t >= T) return;
    int s0[4], s1[4]; float w0[4], w1[4]; P8Raw cur, nx;
    p8_route(F, t, s0, w0);
    if (t + stride < T) p8_route(F, t + stride, s1, w1);
    p8_load(F, t, s0, w0, cur);
    for (; t < T; t += stride) {
        const int tn = t + stride, tnn = t + 2 * stride;
        if (tn < T) { p8_load(F, tn, s1, w1, nx); if (tnn < T) p8_route(F, tnn, s1, w1); }
        p8_compute(F, t, cur);
        if (tn < T) { cur = nx; }
    }
}

constexpr int N_PHASES = 11;
struct Args { const float* in[20]; float* out; unsigned char* ws; int ph_lo, ph_hi, li, pad; };
__global__ void __launch_bounds__(NTHR, 2) fwd_kernel(Args args) {
    extern __shared__ __attribute__((aligned(16))) unsigned char lds[];
    Frame F;
    F.lds = (LAS unsigned char*)lds; F.MISC = (volatile LAS unsigned*)(F.lds + MISC_OFF);
    F.tid = threadIdx.x; F.lane = F.tid & 63; F.wave = __builtin_amdgcn_readfirstlane(F.tid >> 6);
    F.G = gridDim.x; F.bid = blockIdx.x;
#pragma unroll
    for (int i = 0; i < 20; ++i) F.in[i] = args.in[i];
    F.out = args.out; F.ws = args.ws; F.ctl = (gu32*)(args.ws + WS_CTL);
    for (int u = F.tid; u < (LDS_BYTES - LDSCTL_OFF) / 4; u += NTHR) ((LAS unsigned*)(F.lds + LDSCTL_OFF))[u] = 0u;
    __syncthreads();
    const int lo = args.ph_lo, hi = args.ph_hi;
    const bool multi = (hi - lo) > 1;
    XcdBarrier bar; bar.bar = (unsigned*)(F.ctl + CW_BAR) + args.li * XCD_BAR_WORDS; bar.x = 0; bar.st = nullptr;
    if (multi) bar = xcd_barrier_post((unsigned*)(F.ctl + CW_BAR) + args.li * XCD_BAR_WORDS, F.MISC + 8);
#define IN(k) (lo <= (k) && (k) < hi)
#define REPS(k) _Pragma("unroll") for (int _rep = 0; _rep < (((k) == PROBE_PHASE) ? PROBE_REPS : 1); ++_rep)
#define SEAM(k) do { if (IN(k) && IN((k) + 1)) { xcd_barrier(bar); if (PROBE_PHASE == 112) { xcd_barrier(bar); xcd_barrier(bar); } } } while (0)
    const int gw = F.bid * NWAVES + F.wave, NGW = F.G * NWAVES;

    const int _pass = args.li;
    unsigned long long tp_acc = 0, tp_t0 = 0; const bool tp_on = (PROBE_PHASE >= 200) && (F.bid == 0);
#define TP_BEGIN(k) do { if (tp_on && ((k) == PROBE_PHASE - 200 || PROBE_PHASE == 299 && (k) == 0)) tp_t0 = __builtin_amdgcn_s_memrealtime(); } while (0)
#define TP_END(k) do { if (tp_on && ((k) == PROBE_PHASE - 200 || PROBE_PHASE == 299 && (k) == 10)) tp_acc += __builtin_amdgcn_s_memrealtime() - tp_t0; } while (0)
    if (PROBE_PHASE == 102) { unsigned acc_ = 0; const size_t gt_ = (size_t)F.bid * NTHR + F.tid, ng_ = (size_t)F.G * NTHR;
        for (size_t pg = gt_; pg < WS_END / 4096; pg += ng_) acc_ += *(const volatile unsigned*)(F.ws + pg * 4096);
        const size_t insz[5] = {(size_t)T * D * 4, (size_t)NE * D * 2 * DFF * 4, (size_t)NE * DFF * D * 4, (size_t)D * 6 * D * 4, (size_t)D * 3072 * 4}; const float* inp[5] = {F.in[I_X], F.in[I_W1], F.in[I_W2], F.in[I_ADAW], F.in[I_WIN]};
        _Pragma("unroll") for (int q = 0; q < 5; ++q) for (size_t pg = gt_; pg < insz[q] / 4096; pg += ng_) acc_ += *(const volatile unsigned*)((const char*)inp[q] + pg * 4096);
        asm volatile("" :: "v"(acc_)); __syncthreads(); }
    if (PROBE_PHASE == 103) { unsigned long long pc_; asm volatile("s_getpc_b64 %0" : "=s"(pc_)); const char* cb_ = (const char*)(pc_ & ~0xFFull); unsigned acc_ = 0;
        for (int off = F.tid * 64; off < 96 * 1024; off += NTHR * 64) acc_ += *(const volatile unsigned*)(cb_ + off);
        asm volatile("" :: "v"(acc_)); }
    if (PROBE_PHASE == 105) { const unsigned long long t0 = __builtin_amdgcn_s_memrealtime(); f32x4 acc_ = (f32x4){0.f,0.f,0.f,0.f}; const f32x4* src_ = (const f32x4*)F.in[I_W1]; size_t idx_ = (size_t)F.bid * NTHR + F.tid; const size_t n4_ = (size_t)NE * D * 2 * DFF / 4;
        while (__builtin_amdgcn_s_memrealtime() - t0 < (unsigned long long)PROBE_REPS * 100ull) { _Pragma("unroll") for (int i = 0; i < 8; ++i) { acc_ += src_[idx_]; idx_ += (size_t)F.G * NTHR; if (idx_ >= n4_) idx_ -= n4_; } }
        asm volatile("" :: "v"(acc_)); __syncthreads(); }
    if (PROBE_PHASE == 107 && args.pad == 77) { f32x4 acc_ = (f32x4){0.f,0.f,0.f,0.f}; const size_t gt_ = (size_t)F.bid * NTHR + F.tid, ng_ = (size_t)F.G * NTHR;
        { const f32x4* src_ = (const f32x4*)F.in[I_W1]; const size_t n4_ = (size_t)NE * D * 2 * DFF / 4; for (size_t i = gt_; i < n4_; i += ng_) acc_ += src_[i]; }
        { const f32x4* src_ = (const f32x4*)F.in[I_W2]; const size_t n4_ = (size_t)NE * D * DFF / 4; for (size_t i = gt_; i < n4_; i += ng_) acc_ += src_[i]; }
        asm volatile("" :: "v"(acc_)); }
    if (PROBE_PHASE == 108 && args.pad == 78) { const size_t gt_ = (size_t)F.bid * NTHR + F.tid, ng_ = (size_t)F.G * NTHR; v4u* dst_ = (v4u*)(F.ws + WS_WB1); const size_t n_ = (size_t)192 * MiB / 16;
        for (size_t i = gt_; i < n_; i += ng_) dst_[i] = (v4u){0u, 0u, 0u, 0u}; }
    if (PROBE_PHASE == 109) { asm volatile(".rept 16384\n s_nop 0\n .endr" ::: "memory"); }
    if (PROBE_PHASE == 110) { const unsigned long long t0 = __builtin_amdgcn_s_memrealtime(); f32x4 ac_ = (f32x4){0.f,0.f,0.f,0.f}; bf16x8 aa_, bb_; for (int i = 0; i < 8; ++i) { aa_[i] = (short)(0x3f80 + F.lane); bb_[i] = (short)(0x3c00 + i); }
        while (__builtin_amdgcn_s_memrealtime() - t0 < (unsigned long long)PROBE_REPS * 100ull) { _Pragma("unroll") for (int i = 0; i < 32; ++i) ac_ = __builtin_amdgcn_mfma_f32_16x16x32_bf16(aa_, bb_, ac_, 0, 0, 0); }
        asm volatile("" :: "v"(ac_)); }
    if (PROBE_PHASE == 101) { const unsigned long long t0 = __builtin_amdgcn_s_memrealtime(); float xa = (float)F.tid, xb = 1.0001f; while (__builtin_amdgcn_s_memrealtime() - t0 < 20000ull) { _Pragma("unroll") for (int i = 0; i < 64; ++i) xa = fmaf(xa, xb, 0.5f); } asm volatile("" :: "v"(xa)); }
    TP_BEGIN(0);
    if (IN(0)) REPS(0) { p0_prologue(F, args.pad ? args.pad : 3); }
    SEAM(0);
    TP_END(0);
    TP_BEGIN(1);
    if (IN(1)) REPS(1) { p1_phase(F); }
    SEAM(1);
    TP_END(1);
    TP_BEGIN(2);
    if (IN(2)) REPS(2) {
        SchedInproj S{F.G, F.bid, (const char*)(F.ws + WS_HMOD), (const char*)(F.ws + WS_WINT), (char*)(F.ws + WS_PX), (char*)(F.ws + WS_PT)};
        pg8::EpiStoreBf16 E;
        pg8::gemm_phase(F.lds, D * 2, (size_t)128 * D * 2, (size_t)128 * D * 2, S, E);
    }
    SEAM(2);
    TP_END(2);
    TP_BEGIN(3);
    if (IN(3)) {
        REPS(30) { for (int ch = F.bid; ch < 256; ch += F.G) p3_gla_chunked(F, ch); }
        REPS(31) {
        SchedFourier S{F.G, F.bid, (const char*)(F.ws + WS_DFT), (const char*)(F.ws + WS_PT), (char*)(F.ws + WS_EO)};
        pg8::EpiStoreBf16 E;
        pg8::gemm_phase(F.lds, SEQ * 2, (size_t)128 * SEQ * 2, (size_t)128 * SEQ * 2, S, E);
        }
    }
    SEAM(3);
    TP_END(3);
    TP_BEGIN(4);
    if (IN(4)) REPS(4) { p3c_rows(F, gw, NGW); }
    SEAM(4);
    TP_END(4);
    TP_BEGIN(5);
    if (IN(5)) REPS(5) {
        SchedWout S{F.G, F.bid, (const char*)(F.ws + WS_MIX), (const char*)(F.ws + WS_WOUT)};
        pg8::EpiWout E{F.in[I_X], (const float*)(F.ws + WS_POS), (const float*)(F.ws + WS_MOD), (float*)(F.ws + WS_X2)};
        pg8::gemm_phase(F.lds, D * 2, (size_t)128 * D * 2, (size_t)128 * D * 2, S, E);
    }
    SEAM(5);
    TP_END(5);
    TP_BEGIN(6);
    if (IN(6)) REPS(6) { __syncthreads(); p5a_phase(F, CW_CNT0 + 32 * (_rep + _pass)); }
    SEAM(6);
    TP_END(6);
    TP_BEGIN(7);
    if (IN(7)) REPS(7) { p5c_phase(F); }
    SEAM(7);
    TP_END(7);
    TP_BEGIN(8);
    if (IN(8)) REPS(8) {
        volatile LAS unsigned* boff = F.MISC + 16; moe_offsets(F, boff);
        SchedMoe<8, 1> S; S.init(F, boff, (const char*)(F.ws + WS_HMP), (const char*)(F.ws + WS_WB1));
        pg8::EpiMoe1 E{F.in[I_B1], F.ws + WS_HH};
        pg8::gemm_phase<pg8::EpiMoe1, SchedMoe<8, 1>, true>(F.lds, D, (size_t)128 * D, (size_t)DFF * D, S, E);
    }
    SEAM(8);
    TP_END(8);
    TP_BEGIN(9);
    if (IN(9)) REPS(9) {
        volatile LAS unsigned* boff = F.MISC + 16; moe_offsets(F, boff);
        SchedMoe<4, 2> S; S.init(F, boff, (const char*)(F.ws + WS_HH), (const char*)(F.ws + WS_WB2));
        pg8::EpiMoe2 E{F.in[I_B2], (bf16*)(F.ws + WS_YS)};
        pg8::gemm_phase<pg8::EpiMoe2, SchedMoe<4, 2>, true>(F.lds, DFF, (size_t)128 * DFF, (size_t)128 * DFF, S, E);
    }
    SEAM(9);
    TP_END(9);
    TP_BEGIN(10);
    if (IN(10)) REPS(10) { p8_rows(F, gw, NGW); }
    TP_END(10);
    if (tp_on) { const unsigned long long mult = (PROBE_PHASE == 299) ? 1ull : 4ull; const unsigned long long t1 = __builtin_amdgcn_s_memrealtime(); while (__builtin_amdgcn_s_memrealtime() - t1 < mult * tp_acc) __builtin_amdgcn_s_sleep(8); }
#undef IN
#undef SEAM
}

__global__ void zero_ctl_kernel(unsigned* p, int n) { const int i = blockIdx.x * blockDim.x + threadIdx.x; if (i < n) p[i] = 0u; }
extern "C" void kernel_launch(void* const* d_in, const int* in_sizes, int n_in, void* d_out, int out_size, void* d_ws, size_t ws_size, hipStream_t stream) {
    static int grid = 0;
    if (grid == 0) {
        if (n_in != 20 || out_size != T * D || ws_size < WS_END) { fprintf(stderr, "kernel_launch: unexpected shapes (n_in %d out %d ws %zu need %zu)\n", n_in, out_size, ws_size, (size_t)WS_END); grid = -1; return; }
        int dev = 0, cus = 0, per_cu = 0;
        if (hipGetDevice(&dev) != hipSuccess || hipDeviceGetAttribute(&cus, hipDeviceAttributeMultiprocessorCount, dev) != hipSuccess) { grid = -1; return; }
        if (hipFuncSetAttribute((const void*)fwd_kernel, hipFuncAttributeMaxDynamicSharedMemorySize, LDS_BYTES) != hipSuccess) { fprintf(stderr, "kernel_launch: hipFuncSetAttribute failed\n"); grid = -1; return; }
        if (hipOccupancyMaxActiveBlocksPerMultiprocessor(&per_cu, (const void*)fwd_kernel, NTHR, LDS_BYTES) != hipSuccess || per_cu < 1) { fprintf(stderr, "kernel_launch: occupancy query says %d\n", per_cu); }
        (void)hipGetLastError();
        grid = cus;
    }
    if (grid < 0) return;
    if (PROBE_PHASE == 111) { hipLaunchKernelGGL(zero_ctl_kernel, dim3(CTL_ZERO_BYTES / 4 / 256), dim3(256), 0, stream, (unsigned*)d_ws, (int)(CTL_ZERO_BYTES / 4)); }
    else if (hipMemsetAsync((char*)d_ws + WS_CTL, 0, CTL_ZERO_BYTES, stream) != hipSuccess) return;
    Args a{};
    for (int i = 0; i < 20; ++i) a.in[i] = (const float*)d_in[i];
    a.out = (float*)d_out; a.ws = (unsigned char*)d_ws;
#if MK_N_LAUNCHES == 1
    a.ph_lo = 0; a.ph_hi = N_PHASES;
    for (int li = 0; li < NPASS; ++li) { a.li = li; if (PROBE_PHASE == 104) { a.ph_lo = (li == 0) ? PROBE_REPS - 1 : 0; a.ph_hi = (li == 0) ? PROBE_REPS : N_PHASES; }
        if (PROBE_PHASE == 107) { a.ph_lo = 0; a.ph_hi = (li == 0) ? 0 : N_PHASES; a.pad = (li == 0) ? 77 : 0; }
        if (PROBE_PHASE == 108) { a.ph_lo = 0; a.ph_hi = (li == 0) ? 0 : N_PHASES; a.pad = (li == 0) ? 78 : 0; }
        if (PROBE_PHASE == 106) { a.ph_lo = 0; a.ph_hi = (li == 0) ? 1 : N_PHASES; a.pad = (li == 0) ? PROBE_REPS : 0; } hipLaunchKernelGGL(fwd_kernel, dim3(grid), dim3(NTHR), LDS_BYTES, stream, a); }
#else
    for (int p = 0; p < N_PHASES; ++p) { a.ph_lo = p; a.ph_hi = p + 1; hipLaunchKernelGGL(fwd_kernel, dim3(grid), dim3(NTHR), LDS_BYTES, stream, a); }
#endif
}
```
